# Optimizing an MI355X kernel written in HIP

```python
import jax, jax.numpy as jnp
from jax import lax
import numpy as np

D_MODEL = 1024
BATCH = 4
SEQ = 4096
DEPTH = 1
DEC_BATCH = 32
DEC_SEQ = 64
PAST_LEN = 2048

CHUNK = 64
D_CONV = D_MODEL
CONV_A_WIDTH = 3
N_HEADS = 8
HEAD_K = 128
HEAD_V = 128
KEY_DIM = N_HEADS * HEAD_K
VAL_DIM = N_HEADS * HEAD_V
QKV_DIM = 2 * KEY_DIM + VAL_DIM
CONV_B_WIDTH = 4
D_FF = 4 * D_MODEL
N_ADA = 6
EPS = 1e-6
IN_SPLITS = (D_CONV, D_CONV, D_CONV, KEY_DIM, KEY_DIM, VAL_DIM, VAL_DIM, N_HEADS, N_HEADS, D_MODEL, D_MODEL)
D_IN = sum(IN_SPLITS)

kernel_name = 'hybrid_shortconv_gdn_stream_step'


def rmsnorm(x, g):
    xf = x.astype(jnp.float32)
    y = xf * lax.rsqrt(jnp.mean(xf * xf, axis=-1, keepdims=True) + EPS)
    return (y * g.astype(jnp.float32)).astype(x.dtype)


def l2norm(x):
    return x * lax.rsqrt(jnp.sum(x * x, axis=-1, keepdims=True) + EPS)


def causal_dwconv(x, past, w):
    width = w.shape[0]
    t = x.shape[1]
    xp = jnp.concatenate([past.astype(x.dtype), x], axis=1)
    y = xp[:, 0:t] * w[0]
    for j in range(1, width):
        y = y + xp[:, j:j + t] * w[j]
    return y, xp[:, -(width - 1):]


def gated_delta_rule(q, k, v, g, beta, s0):
    b_, t, h, dk = q.shape
    dv = v.shape[-1]
    blen = min(CHUNK, t)
    n = t // blen

    def blk(a):
        a = a.reshape((b_, n, blen) + a.shape[2:])
        return jnp.moveaxis(jnp.moveaxis(a, 3, 2), 1, 0)

    qc, kc, vc, gc, bc = blk(q), blk(k), blk(v), blk(g), blk(beta)
    gcum = jnp.cumsum(gc, axis=-1)
    idx = jnp.arange(blen)
    incl = idx[:, None] >= idx[None, :]
    strict = idx[:, None] > idx[None, :]
    decay = jnp.exp(jnp.where(incl, gcum[..., :, None] - gcum[..., None, :], -jnp.inf))
    kk = jnp.einsum('nbhid,nbhjd->nbhij', kc, kc)
    a_mat = jnp.where(strict, bc[..., :, None] * kk * decay, 0.0)
    eye = jnp.eye(blen, dtype=q.dtype)
    rhs = jnp.concatenate([kc * (bc * jnp.exp(gcum))[..., None], vc * bc[..., None]], axis=-1)
    sol = lax.linalg.triangular_solve(eye + a_mat, rhs, left_side=True, lower=True)
    w_c, u_c = sol[..., :dk], sol[..., dk:]
    qk = jnp.where(incl, jnp.einsum('nbhid,nbhjd->nbhij', qc, kc) * decay, 0.0)
    q_dec = qc * jnp.exp(gcum)[..., None]
    k_dec = kc * jnp.exp(gcum[..., -1:] - gcum)[..., None]
    g_last = jnp.exp(gcum[..., -1])

    def step(s, xs):
        w_i, u_i, qk_i, qd_i, kd_i, gl_i = xs
        v_new = u_i - jnp.einsum('bhld,bhde->bhle', w_i, s)
        o = jnp.einsum('bhld,bhde->bhle', qd_i, s) + jnp.einsum('bhij,bhje->bhie', qk_i, v_new)
        s = s * gl_i[..., None, None] + jnp.einsum('bhld,bhle->bhde', kd_i, v_new)
        return s, o

    s_fin, o = lax.scan(step, s0, (w_c, u_c, qk, q_dec, k_dec, g_last))
    o = jnp.moveaxis(jnp.moveaxis(o, 0, 1), 2, 3).reshape(b_, t, h, dv)
    return o, s_fin


def token_mixer(hn, conv_a_past, qkv_past, s0, w_in, conv_a_w, conv_qkv_w, a_log, dt_bias, out_norm_g, w_a_out, w_b_out, w_o):
    b_, t, _ = hn.shape
    proj = hn @ w_in
    split_at = np.cumsum(IN_SPLITS)[:-1].tolist()
    pb, pc, ph, q, k, v, z, a, bb, ga, gb = jnp.split(proj, split_at, axis=-1)
    ya, conv_a_new = causal_dwconv(pc * ph, conv_a_past, conv_a_w)
    ya = (pb * ya) @ w_a_out
    qkv, qkv_new = causal_dwconv(jnp.concatenate([q, k, v], axis=-1), qkv_past, conv_qkv_w)
    qkv = jax.nn.silu(qkv).astype(jnp.float32)
    q, k, v = jnp.split(qkv, [KEY_DIM, 2 * KEY_DIM], axis=-1)
    q = l2norm(q.reshape(b_, t, N_HEADS, HEAD_K)) * (HEAD_K ** -0.5)
    k = l2norm(k.reshape(b_, t, N_HEADS, HEAD_K))
    v = v.reshape(b_, t, N_HEADS, HEAD_V)
    g = -jnp.exp(a_log.astype(jnp.float32)) * jax.nn.softplus(a.astype(jnp.float32) + dt_bias.astype(jnp.float32))
    beta = jax.nn.sigmoid(bb.astype(jnp.float32))
    o, s_new = gated_delta_rule(q, k, v, g, beta, s0.astype(jnp.float32))
    o = rmsnorm(o, out_norm_g) * jax.nn.silu(z.reshape(b_, t, N_HEADS, HEAD_V).astype(jnp.float32))
    yb = o.reshape(b_, t, VAL_DIM).astype(hn.dtype) @ w_b_out
    y = (jax.nn.sigmoid(ga) * ya + jax.nn.sigmoid(gb) * yb) @ w_o
    return y, conv_a_new, qkv_new, s_new.astype(hn.dtype)


def trunk(x, c, conv_a_st, conv_qkv_st, delta_st, ada_w, ada_b, norm1_g, norm2_g, w_in, conv_a_w, conv_qkv_w,
          a_log, dt_bias, out_norm_g, w_a_out, w_b_out, w_o, w_ff1, w_ff2, final_ada_w, final_ada_b, final_norm_g):
    c_act = jax.nn.silu(c)
    new_a, new_qkv, new_s = [], [], []
    for l in range(DEPTH):
        mod = (c_act @ ada_w[l] + ada_b[l])[:, None, :]
        sh1, sc1, gt1, sh2, sc2, gt2 = jnp.split(mod, N_ADA, axis=-1)
        hn = rmsnorm(x, norm1_g[l]) * (1 + sc1) + sh1
        y, ca, cq, s = token_mixer(hn, conv_a_st[l], conv_qkv_st[l], delta_st[l], w_in[l], conv_a_w[l], conv_qkv_w[l],
                                   a_log[l], dt_bias[l], out_norm_g[l], w_a_out[l], w_b_out[l], w_o[l])
        x = x + gt1 * y
        hn = rmsnorm(x, norm2_g[l]) * (1 + sc2) + sh2
        x = x + gt2 * (jnp.square(jax.nn.relu(hn @ w_ff1[l])) @ w_ff2[l])
        new_a.append(ca)
        new_qkv.append(cq)
        new_s.append(s)
    modf = (c_act @ final_ada_w + final_ada_b)[:, None, :]
    shf, scf = jnp.split(modf, 2, axis=-1)
    y = rmsnorm(x, final_norm_g) * (1 + scf) + shf
    return y, jnp.stack(new_a), jnp.stack(new_qkv), jnp.stack(new_s)


def setup_inputs(seed: int = 0) -> dict:
    key = jax.random.key(seed)
    ks = jax.random.split(key, 32)
    nrm = lambda k, shape, s: jax.random.normal(k, shape, jnp.float32) * s
    L = DEPTH
    dt = jnp.exp(jax.random.uniform(ks[20], (L, N_HEADS), jnp.float32, np.log(1e-3), np.log(1e-1)))
    return {
        'x_prompt': nrm(ks[0], (BATCH, SEQ, D_MODEL), 1.0),
        'x_sample': nrm(ks[1], (DEC_BATCH, DEC_SEQ, D_MODEL), 1.0),
        'cache_conv_a': nrm(ks[2], (L, DEC_BATCH, CONV_A_WIDTH - 1, D_CONV), 1.0),
        'cache_conv_qkv': nrm(ks[3], (L, DEC_BATCH, CONV_B_WIDTH - 1, QKV_DIM), 1.0),
        'state_delta': nrm(ks[4], (L, DEC_BATCH, N_HEADS, HEAD_K, HEAD_V), 0.1),
        'c_prompt': nrm(ks[5], (BATCH, D_MODEL), 1.0),
        'c_sample': nrm(ks[6], (DEC_BATCH, D_MODEL), 1.0),
        'ada_w': nrm(ks[7], (L, D_MODEL, N_ADA * D_MODEL), D_MODEL ** -0.5),
        'ada_b': nrm(ks[8], (L, N_ADA * D_MODEL), 0.02),
        'norm1_g': 1.0 + nrm(ks[9], (L, D_MODEL), 0.02),
        'norm2_g': 1.0 + nrm(ks[10], (L, D_MODEL), 0.02),
        'w_in': nrm(ks[11], (L, D_MODEL, D_IN), D_MODEL ** -0.5),
        'conv_a_w': nrm(ks[12], (L, CONV_A_WIDTH, D_CONV), CONV_A_WIDTH ** -0.5),
        'conv_qkv_w': nrm(ks[13], (L, CONV_B_WIDTH, QKV_DIM), CONV_B_WIDTH ** -0.5),
        'a_log': jnp.log(jax.random.uniform(ks[14], (L, N_HEADS), jnp.float32, 1.0, 16.0)),
        'dt_bias': dt + jnp.log(-jnp.expm1(-dt)),
        'out_norm_g': 1.0 + nrm(ks[15], (L, HEAD_V), 0.02),
        'w_a_out': nrm(ks[16], (L, D_CONV, D_MODEL), D_CONV ** -0.5),
        'w_b_out': nrm(ks[17], (L, VAL_DIM, D_MODEL), VAL_DIM ** -0.5),
        'w_o': nrm(ks[18], (L, D_MODEL, D_MODEL), D_MODEL ** -0.5),
        'w_ff1': nrm(ks[19], (L, D_MODEL, D_FF), D_MODEL ** -0.5),
        'w_ff2': nrm(ks[21], (L, D_FF, D_MODEL), D_FF ** -0.5),
        'final_ada_w': nrm(ks[22], (D_MODEL, 2 * D_MODEL), D_MODEL ** -0.5),
        'final_ada_b': nrm(ks[23], (2 * D_MODEL,), 0.02),
        'final_norm_g': 1.0 + nrm(ks[24], (D_MODEL,), 0.02),
    }


def reference(x_prompt, x_sample, cache_conv_a, cache_conv_qkv, state_delta, c_prompt, c_sample, ada_w, ada_b,
              norm1_g, norm2_g, w_in, conv_a_w, conv_qkv_w, a_log, dt_bias, out_norm_g, w_a_out, w_b_out, w_o,
              w_ff1, w_ff2, final_ada_w, final_ada_b, final_norm_g):
    dt_ = x_prompt.dtype
    zero_a = jnp.zeros((DEPTH, BATCH, CONV_A_WIDTH - 1, D_CONV), dt_)
    zero_qkv = jnp.zeros((DEPTH, BATCH, CONV_B_WIDTH - 1, QKV_DIM), dt_)
    zero_s = jnp.zeros((DEPTH, BATCH, N_HEADS, HEAD_K, HEAD_V), dt_)
    y_prompt, conv_a_p, conv_qkv_p, delta_p = trunk(
        x_prompt, c_prompt, zero_a, zero_qkv, zero_s, ada_w, ada_b, norm1_g, norm2_g, w_in, conv_a_w, conv_qkv_w,
        a_log, dt_bias, out_norm_g, w_a_out, w_b_out, w_o, w_ff1, w_ff2, final_ada_w, final_ada_b, final_norm_g)
    y_sample, conv_a_s, conv_qkv_s, delta_s = trunk(
        x_sample, c_sample, cache_conv_a, cache_conv_qkv, state_delta, ada_w, ada_b, norm1_g, norm2_g, w_in,
        conv_a_w, conv_qkv_w, a_log, dt_bias, out_norm_g, w_a_out, w_b_out, w_o, w_ff1, w_ff2, final_ada_w,
        final_ada_b, final_norm_g)
    return (y_prompt, y_sample, conv_a_p, conv_qkv_p, delta_p, conv_a_s, conv_qkv_s, delta_s)
```

```cpp
#include <hip/hip_runtime.h>
#include <hip/hip_cooperative_groups.h>
#include <cstdio>
#include <cstdint>
namespace cg = cooperative_groups;

#define LAS __attribute__((address_space(3)))
typedef unsigned short bf16;
typedef short bf16x8 __attribute__((ext_vector_type(8)));
typedef float f32x4 __attribute__((ext_vector_type(4)));
typedef unsigned u32x4 __attribute__((ext_vector_type(4)));
typedef unsigned u32x2 __attribute__((ext_vector_type(2)));

constexpr int D = 1024, MTOK = 18432, MPROMPT = 16384, NB = 36, FF = 4096;
constexpr int NCHUNK = 288;
constexpr float EPS = 1e-6f;
constexpr size_t MiB = 1u << 20;
constexpr size_t WS_MOD = 0, WS_MODF = 1 * MiB, WS_G = 2 * MiB, WS_BETA = 3 * MiB, WS_HALO = 4 * MiB, WS_GC = 10 * MiB, WS_BAR = 11 * MiB, BAR_BYTES = 16384;
constexpr size_t WS_WIN = 12 * MiB, WS_WA = 31 * MiB, WS_WB = 33 * MiB, WS_WO = 35 * MiB;
constexpr size_t WS_XN = 38 * MiB, WS_R3 = 74 * MiB, WS_R1 = 110 * MiB, WS_R2 = 218 * MiB, WS_END = 254 * MiB;
constexpr size_t WS_WFF1 = WS_R3, WS_WFF2 = WS_R3 + 8 * MiB;
constexpr int LDS_BYTES = 147456;
constexpr size_t O_CONVA_P = 18874368, O_CONVQ_P = 18882560, O_DELTA_P = 18919424, O_CONVA_S = 19443712, O_CONVQ_S = 19509248, O_DELTA_S = 19804160;

struct Params {
    const float *x_prompt, *x_sample, *cache_conv_a, *cache_conv_qkv, *state_delta, *c_prompt, *c_sample,
        *ada_w, *ada_b, *norm1_g, *norm2_g, *w_in, *conv_a_w, *conv_qkv_w, *a_log, *dt_bias, *out_norm_g,
        *w_a_out, *w_b_out, *w_o, *w_ff1, *w_ff2, *final_ada_w, *final_ada_b, *final_norm_g;
    float* out; unsigned char* ws;
};
typedef const __attribute__((address_space(4))) Params* KP;
__device__ __forceinline__ KP kp_get() { KP k = (KP)__builtin_amdgcn_kernarg_segment_ptr(); asm volatile("" : "+s"(k)); return k; }

typedef float f32x2_t __attribute__((ext_vector_type(2)));
typedef __bf16 bf16x2_t __attribute__((ext_vector_type(2)));
__device__ __forceinline__ unsigned pk2(float lo, float hi) { f32x2_t v = {lo, hi}; bf16x2_t b = __builtin_convertvector(v, bf16x2_t); return __builtin_bit_cast(unsigned, b); }
__device__ __forceinline__ unsigned f2bf(float f) { return pk2(f, 0.f) & 0xffffu; }
__device__ __forceinline__ float bflo(unsigned w) { return __builtin_bit_cast(float, w << 16); }
__device__ __forceinline__ float bfhi(unsigned w) { return __builtin_bit_cast(float, w & 0xffff0000u); }
__device__ __forceinline__ float bf2f(bf16 v) { return __builtin_bit_cast(float, ((unsigned)v) << 16); }
__device__ __forceinline__ float sigmoidf_(float x) { return __builtin_amdgcn_rcpf(1.f + __expf(-x)); }
__device__ __forceinline__ float siluf_(float x) { return x * __builtin_amdgcn_rcpf(1.f + __expf(-x)); }
template <int CTRL> __device__ __forceinline__ float dpp_mov(float v) { return __builtin_bit_cast(float, __builtin_amdgcn_update_dpp(0, __builtin_bit_cast(int, v), CTRL, 0xF, 0xF, true)); }
__device__ __forceinline__ float row16_sum(float v) {
    v += dpp_mov<0xB1>(v);
    v += dpp_mov<0x4E>(v);
    v += dpp_mov<0x141>(v);
    v += dpp_mov<0x140>(v);
    return v;
}
__device__ __forceinline__ float wave_sum(float v) {
    v = row16_sum(v);
    const int vi = __builtin_bit_cast(int, v);
    const float r0 = __builtin_bit_cast(float, __builtin_amdgcn_readlane(vi, 0)), r1 = __builtin_bit_cast(float, __builtin_amdgcn_readlane(vi, 16));
    const float r2 = __builtin_bit_cast(float, __builtin_amdgcn_readlane(vi, 32)), r3 = __builtin_bit_cast(float, __builtin_amdgcn_readlane(vi, 48));
    return (r0 + r1) + (r2 + r3);
}
__device__ __forceinline__ int batch_of(int r) { return r < MPROMPT ? (r >> 12) : 4 + ((r - MPROMPT) >> 6); }
#define LDS_WAIT() asm volatile("s_waitcnt lgkmcnt(0)" ::: "memory")

#define XB_TMO      128
#define XB_XCNT(j)  (256  + 64 * (j))
#define XB_XSUB(j)  (1280 + 64 * (j))
#define XB_XGEN(j)  (2304 + 64 * (j))
#define XB_TOP      3328
#define XB_TOPGEN   3392
#define XCD_BAR_WORDS 3456
#define XB_SPIN_CAP (1u << 18)

__device__ __forceinline__ unsigned xb_ld(unsigned* p)              { return __hip_atomic_load(p, __ATOMIC_RELAXED, __HIP_MEMORY_SCOPE_AGENT); }
__device__ __forceinline__ unsigned xb_add(unsigned* p, unsigned v) { return __hip_atomic_fetch_add(p, v, __ATOMIC_RELAXED, __HIP_MEMORY_SCOPE_AGENT); }
__device__ __forceinline__ unsigned xb_xcc_id() { return (unsigned)__builtin_amdgcn_s_getreg((3 << 11) | 20) & 0xFu; }
#define XB_SPIN(cond, bar) do { unsigned _sp = 0; while (cond) { __builtin_amdgcn_s_sleep(1); \
    if ((++_sp & 255u) == 0u) { if (xb_ld(&(bar)[XB_TMO])) break; if (_sp > XB_SPIN_CAP) { atomicAdd(&(bar)[XB_TMO], 1u); break; } } } } while (0)

struct XcdBarrier {
    unsigned* bar; unsigned x;
    volatile LAS unsigned* st;
};

__device__ __forceinline__ XcdBarrier xcd_barrier_post(unsigned* bar, volatile LAS unsigned* st) {
    XcdBarrier b; b.bar = bar; b.x = xb_xcc_id(); b.st = st;
    if (threadIdx.x == 0) (void)xb_add(&bar[XB_XCNT(b.x)], 1u);
    return b;
}
__device__ __forceinline__ void xcd_barrier_complete(unsigned* bar, unsigned x, unsigned& nloc, unsigned& nx) {
    const unsigned G = gridDim.x * gridDim.y * gridDim.z;
    unsigned sum, cnt, mine, sp = 0u;
    for (;;) {
        sum = 0u; cnt = 0u; mine = 0u;
#pragma unroll
        for (unsigned j = 0; j < 16; ++j) { const unsigned c = xb_ld(&bar[XB_XCNT(j)]); sum += c; cnt += (c > 0u) ? 1u : 0u; mine = (j == x) ? c : mine; }
        if (sum == G) break;
        __builtin_amdgcn_s_sleep(1);
        if ((++sp & 255u) == 0u) { if (xb_ld(&bar[XB_TMO])) break; if (sp > XB_SPIN_CAP) { atomicAdd(&bar[XB_TMO], 1u); break; } }
    }
    nloc = mine > 0u ? mine : 1u; nx = cnt > 0u ? cnt : 1u;
}

__device__ __forceinline__ void xcd_barrier(const XcdBarrier& b) {
    asm volatile("s_waitcnt vmcnt(0)" ::: "memory");
    __syncthreads();
    if (threadIdx.x == 0) {
        unsigned* bar = b.bar;
        __builtin_amdgcn_s_waitcnt(0);
        unsigned nloc = b.st[0], nx = b.st[1];
        if (nloc == 0u) { xcd_barrier_complete(bar, b.x, nloc, nx); b.st[0] = nloc; b.st[1] = nx; }
        const unsigned old = xb_add(&bar[XB_XSUB(b.x)], 1u);
        const unsigned gen = old / nloc;
        if (old + 1u == (gen + 1u) * nloc) {
            __builtin_amdgcn_fence(__ATOMIC_RELEASE, "agent");
            asm volatile("s_waitcnt vmcnt(0)" ::: "memory");
            const unsigned og = xb_add(&bar[XB_TOP], 1u);
            const unsigned tg = og / nx;
            if (og + 1u == (tg + 1u) * nx) xb_add(&bar[XB_TOPGEN], 1u);
            else XB_SPIN(xb_ld(&bar[XB_TOPGEN]) == tg, bar);
            __builtin_amdgcn_fence(__ATOMIC_ACQUIRE, "agent");
            xb_add(&bar[XB_XGEN(b.x)], 1u);
            asm volatile("s_waitcnt vmcnt(0)" ::: "memory");
        } else {
            XB_SPIN(xb_ld(&bar[XB_XGEN(b.x)]) == gen, bar);
            __builtin_amdgcn_fence(__ATOMIC_ACQUIRE, "agent");
            asm volatile("s_waitcnt vmcnt(0)" ::: "memory");
        }
    }
    __syncthreads();
}


namespace pg8 {
constexpr int BM = 256, BK = 64, HALF = 128, HTB = HALF * BK * 2, STAGE_BYTES = 8 * HTB, NXCD = 8, WGM = 8;
__host__ __device__ __forceinline__ int lds_byte(int r, int c) { const int st = (r >> 4) * 2 + (c >> 5), rr = r & 15, cc = c & 31, ob = rr * 64 + cc * 2; return st * 1024 + (ob ^ (((ob >> 9) & 1) << 5)); }
__host__ __device__ __forceinline__ void stage_rc(int b, int& R, int& C) { const int st = b / 1024, sb = b % 1024, swz = sb ^ (((sb >> 9) & 1) << 5); R = (st >> 1) * 16 + swz / 64; C = (st & 1) * 32 + (swz % 64) / 2; }
__host__ __device__ __forceinline__ int perm32(int rho) { const int n = rho >> 4, i = rho & 15; return 8 * (i >> 2) + 4 * n + (i & 3); }

struct Unit { int pm, pn, kind, aux; const char* A; const char* Bt; };

__device__ __forceinline__ void decode_tile(int L, int nM, int nN, int& pm, int& pn) {
    const int nwg = nM * nN; int wgid = L;
    { const int q = nwg / NXCD, r = nwg % NXCD, xcd = wgid % NXCD, off = wgid / NXCD; wgid = (xcd < r ? xcd * (q + 1) : r * (q + 1) + (xcd - r) * q) + off; }
    const int nig = WGM * nN, gid = wgid / nig, fm = gid * WGM, gsz = (nM - fm) < WGM ? (nM - fm) : WGM;
    pm = fm + ((wgid % nig) % gsz); pn = (wgid % nig) / gsz;
}

template <class Sched, class Epi>
__device__ __forceinline__ void gemm_phase(LAS unsigned char* lds, const int K, const int ldk, const Sched& S, const Epi& E) {
    int tid = threadIdx.x; asm volatile("" : "+v"(tid));
    const int wid = __builtin_amdgcn_readfirstlane(tid >> 6), lane = tid & 63, wr = wid >> 2, wc = wid & 3, fr = lane & 15, fq = lane >> 4;
    const int nt = K / BK;
    unsigned voffA[2], voffB[2];
#pragma unroll
    for (int i = 0; i < 2; ++i) { int R, C; stage_rc(tid * 16 + i * 8192, R, C); const int Rb = (R & ~31) + perm32(R & 31);
        voffA[i] = (unsigned)(R * ldk + C) * 2u; voffB[i] = (unsigned)(Rb * ldk + C) * 2u; }
    const size_t kstep = (size_t)(BK * 2);
    const size_t hstep = (size_t)HALF * ldk * 2;
    const unsigned ldsw = (unsigned)wid * 1024u;
    const int aoff = lds_byte(wr * 64 + fr, fq * 8), boff = lds_byte(wc * 32 + fr, fq * 8);
#define PG8_SA(b, h) (((b) * 2 + (h)) * HTB)
#define PG8_SB(b, h) ((4 + (b) * 2 + (h)) * HTB)
#define PG8_STAGE(bufoff, gbase, voff) do { _Pragma("unroll") for (int _i = 0; _i < 2; ++_i) \
        __builtin_amdgcn_global_load_lds((const unsigned*)((const char*)(gbase) + (voff)[_i]), (LAS unsigned*)(lds + (bufoff) + ldsw + _i * 8192), 16, 0, 0); } while (0)
#define PG8_LDA(dst, b, h) do { _Pragma("unroll") for (int m = 0; m < 4; ++m) _Pragma("unroll") for (int k = 0; k < 2; ++k) dst[m][k] = *(const LAS bf16x8*)(lds + PG8_SA(b, h) + aoff + m * 2048 + k * 1024); } while (0)
#define PG8_LDB(dst, b, h) do { _Pragma("unroll") for (int n = 0; n < 2; ++n) _Pragma("unroll") for (int k = 0; k < 2; ++k) dst[n][k] = *(const LAS bf16x8*)(lds + PG8_SB(b, h) + boff + n * 2048 + k * 1024); } while (0)
#define PG8_MMA(ai, bj, At, Bt) do { __builtin_amdgcn_s_setprio(1); _Pragma("unroll") for (int m = 0; m < 4; ++m) _Pragma("unroll") for (int n = 0; n < 2; ++n) _Pragma("unroll") for (int k = 0; k < 2; ++k) \
        acc[ai][bj][m][n] = __builtin_amdgcn_mfma_f32_16x16x32_bf16(Bt[n][k], At[m][k], acc[ai][bj][m][n], 0, 0, 0); __builtin_amdgcn_s_setprio(0); } while (0)
#define PG8_WAIT_V(n) asm volatile("s_waitcnt vmcnt(" #n ")" ::: "memory")
#define PG8_WAIT_L(n) asm volatile("s_waitcnt lgkmcnt(" #n ")" ::: "memory")
#define PG8_BAR __builtin_amdgcn_s_barrier()
#define PG8_SCHED __builtin_amdgcn_sched_barrier(0)
    Unit cur, nxt; int ui = 0;
    if (!S.next(0, cur)) return;
    f32x4 acc[2][2][4][2];
#pragma unroll
    for (int a = 0; a < 2; ++a)
#pragma unroll
        for (int b = 0; b < 2; ++b)
#pragma unroll
            for (int m = 0; m < 4; ++m)
#pragma unroll
                for (int n = 0; n < 2; ++n) acc[a][b][m][n] = (f32x4){0.f, 0.f, 0.f, 0.f};
    bf16x8 At[4][2], B0[2][2], B1[2][2];
    const char* cA = cur.A; const char* cB = cur.Bt;
    PG8_STAGE(PG8_SB(0, 0), cB, voffB); PG8_STAGE(PG8_SB(0, 1), cB + hstep, voffB); PG8_STAGE(PG8_SA(0, 0), cA, voffA); PG8_STAGE(PG8_SA(0, 1), cA + hstep, voffA);
    if (wr == 1) PG8_BAR;
    PG8_WAIT_V(2); PG8_BAR;
    PG8_STAGE(PG8_SB(1, 0), cB + kstep, voffB); PG8_STAGE(PG8_SA(1, 0), cA + kstep, voffA); PG8_STAGE(PG8_SB(1, 1), cB + hstep + kstep, voffB);
    PG8_WAIT_V(6); PG8_BAR;
    for (;;) {
        const bool has_next = S.next(ui + 1, nxt);
        const char* nA = has_next ? nxt.A : cA; const char* nB = has_next ? nxt.Bt : cB;
        for (int t = 0; t < nt; t += 2) {
            const bool last = (t == nt - 2);
            const char* a1 = cA + (size_t)(t + 1) * kstep;
            const char* a2 = last ? nA : cA + (size_t)(t + 2) * kstep; const char* b2 = last ? nB : cB + (size_t)(t + 2) * kstep;
            const char* a3 = a2 + kstep; const char* b3 = b2 + kstep;
            PG8_LDB(B0, 0, 0); PG8_LDB(B1, 0, 1); PG8_SCHED; PG8_LDA(At, 0, 0); PG8_STAGE(PG8_SA(1, 1), a1 + hstep, voffA);
            PG8_WAIT_V(8); PG8_WAIT_L(0); PG8_BAR; PG8_MMA(0, 0, At, B0); PG8_MMA(0, 1, At, B1); PG8_BAR; PG8_SCHED;
            PG8_LDA(At, 0, 1); PG8_STAGE(PG8_SB(0, 0), b2, voffB); PG8_STAGE(PG8_SB(0, 1), b2 + hstep, voffB); PG8_STAGE(PG8_SA(0, 0), a2, voffA);
            PG8_WAIT_V(8); PG8_WAIT_L(0); PG8_BAR; PG8_MMA(1, 0, At, B0); PG8_MMA(1, 1, At, B1); PG8_BAR; PG8_SCHED;
            PG8_LDB(B0, 1, 0); PG8_LDB(B1, 1, 1); PG8_SCHED; PG8_LDA(At, 1, 0); PG8_STAGE(PG8_SA(0, 1), a2 + hstep, voffA);
            PG8_WAIT_V(8); PG8_WAIT_L(0); PG8_BAR; PG8_MMA(0, 0, At, B0); PG8_MMA(0, 1, At, B1); PG8_BAR; PG8_SCHED;
            PG8_LDA(At, 1, 1); PG8_STAGE(PG8_SB(1, 0), b3, voffB); PG8_STAGE(PG8_SB(1, 1), b3 + hstep, voffB); PG8_STAGE(PG8_SA(1, 0), a3, voffA);
            PG8_WAIT_V(8); PG8_WAIT_L(0); PG8_BAR; PG8_MMA(1, 0, At, B0); PG8_MMA(1, 1, At, B1); PG8_BAR; PG8_SCHED;
        }
        if (wr == 0) PG8_BAR;
        E(acc, cur, wr, wc, fr, fq);
        if (!has_next) break;
#pragma unroll
        for (int a = 0; a < 2; ++a)
#pragma unroll
            for (int b = 0; b < 2; ++b)
#pragma unroll
                for (int m = 0; m < 4; ++m)
#pragma unroll
                    for (int n = 0; n < 2; ++n) acc[a][b][m][n] = (f32x4){0.f, 0.f, 0.f, 0.f};
        cur = nxt; cA = nA; cB = nB; ++ui;
        if (wr == 1) PG8_BAR;
    }
    PG8_WAIT_V(0);
    PG8_BAR;
#undef PG8_SA
#undef PG8_SB
#undef PG8_STAGE
#undef PG8_LDA
#undef PG8_LDB
#undef PG8_MMA
#undef PG8_WAIT_V
#undef PG8_WAIT_L
#undef PG8_BAR
#undef PG8_SCHED
}
}

enum { K_PA = 0, K_PQ, K_AB, K_Z, K_YA, K_GA, K_YB, K_GB, K_O, K_FF1, K_FF2, K_OS, K_FF2S, K_SGT, K_YBS };

struct Epi {
    __device__ __forceinline__ void operator()(const f32x4 (&acc)[2][2][4][2], const pg8::Unit& u, int wr, int wc, int fr, int fq) const {
        const KP P = kp_get();
        unsigned char* ws = P->ws;
        const int kind = u.kind;
        const int rbase = u.pm * 256 + wr * 64 + fr, cbase = u.pn * 256 + wc * 32 + 8 * fq;
#define EPI_PACK(w, v0, v1) do { w.x = pk2(v0[0], v0[1]); w.y = pk2(v0[2], v0[3]); w.z = pk2(v1[0], v1[1]); w.w = pk2(v1[2], v1[3]); } while (0)
        if (kind == K_PA && u.pn >= 4) {
            bf16* base = (bf16*)(ws + WS_R1) + 1024 + 128 * (u.pn - 4) + wc * 32 + 8 * fq;
#pragma unroll
            for (int ai = 0; ai < 2; ++ai)
#pragma unroll
                for (int m = 0; m < 4; ++m) {
                    const f32x4 v0 = acc[ai][0][m][0] * acc[ai][1][m][0], v1 = acc[ai][0][m][1] * acc[ai][1][m][1];
                    u32x4 w; EPI_PACK(w, v0, v1);
                    *(u32x4*)(base + (size_t)(rbase + ai * 128 + m * 16) * 3072) = w;
                }
        } else if (kind == K_PA || kind == K_PQ || kind == K_FF1 || kind == K_Z || kind == K_YA || kind == K_YB) {
            bf16* base; int ld;
            if (kind == K_PA || kind == K_PQ) { base = (bf16*)(ws + WS_R1); ld = 3072; }
            else if (kind == K_FF1) { base = (bf16*)(ws + WS_R1); ld = FF; }
            else if (kind == K_YA) { base = (bf16*)(ws + WS_R3); ld = D; }
            else { base = (bf16*)P->out; ld = D; }
#pragma unroll
            for (int ai = 0; ai < 2; ++ai)
#pragma unroll
                for (int m = 0; m < 4; ++m) {
                    const int r = rbase + ai * 128 + m * 16;
#pragma unroll
                    for (int bj = 0; bj < 2; ++bj) {
                        const int c0 = cbase + bj * 128;
                        f32x4 v0 = acc[ai][bj][m][0], v1 = acc[ai][bj][m][1];
                        if (kind == K_FF1) {
#pragma unroll
                            for (int e = 0; e < 4; ++e) { float x = fmaxf(v0[e], 0.f), y = fmaxf(v1[e], 0.f); v0[e] = x * x; v1[e] = y * y; }
                        } else if (kind == K_Z) {
#pragma unroll
                            for (int e = 0; e < 4; ++e) { v0[e] = siluf_(v0[e]); v1[e] = siluf_(v1[e]); }
                        }
                        u32x4 w; EPI_PACK(w, v0, v1);
                        *(u32x4*)(base + (size_t)r * ld + c0) = w;
                        if (kind == K_PQ && (r & 63) >= 61) *(u32x4*)((bf16*)(ws + WS_HALO) + ((size_t)(r >> 6) * 3 + ((r & 63) - 61)) * 3072 + c0) = w;
                    }
                }
        } else if (kind == K_AB) {
            if (wc == 0 && fq < 2) {
                float ea[8], db[8];
#pragma unroll
                for (int e = 0; e < 8; ++e) { ea[e] = -__expf(P->a_log[e]); db[e] = P->dt_bias[e]; }
#pragma unroll
                for (int ai = 0; ai < 2; ++ai)
#pragma unroll
                    for (int m = 0; m < 4; ++m) {
                        const int r = rbase + ai * 128 + m * 16;
                        const f32x4 v0 = acc[ai][0][m][0], v1 = acc[ai][0][m][1];
                        f32x4 o0, o1;
                        if (fq == 0) {
#pragma unroll
                            for (int e = 0; e < 4; ++e) {
                                const float a0 = v0[e] + db[e], a1 = v1[e] + db[4 + e];
                                const float s0 = a0 > 20.f ? a0 : __logf(1.f + __expf(a0)), s1 = a1 > 20.f ? a1 : __logf(1.f + __expf(a1));
                                o0[e] = ea[e] * s0; o1[e] = ea[4 + e] * s1;
                            }
                            float* g = (float*)(ws + WS_G) + (size_t)r * 8; *(f32x4*)g = o0; *(f32x4*)(g + 4) = o1;
                        } else {
#pragma unroll
                            for (int e = 0; e < 4; ++e) { o0[e] = sigmoidf_(v0[e]); o1[e] = sigmoidf_(v1[e]); }
                            float* g = (float*)(ws + WS_BETA) + (size_t)r * 8; *(f32x4*)g = o0; *(f32x4*)(g + 4) = o1;
                        }
                    }
            }
        } else if (kind == K_GA || kind == K_GB) {
            bf16* ym = (bf16*)(ws + WS_R3); const bf16* yb = (const bf16*)P->out;
#pragma unroll
            for (int am = 0; am < 4; ++am) {
                const int ai = am >> 1, mh = (am & 1) * 2;
                u32x4 a[2][2], b[2][2];
#pragma unroll
                for (int m = 0; m < 2; ++m)
#pragma unroll
                    for (int bj = 0; bj < 2; ++bj) {
                        const size_t o = (size_t)(rbase + ai * 128 + (mh + m) * 16) * D + cbase + bj * 128;
                        a[m][bj] = *(const u32x4*)(ym + o);
                        if (kind == K_GB) b[m][bj] = *(const u32x4*)(yb + o); else b[m][bj] = (u32x4){0u, 0u, 0u, 0u};
                    }
#pragma unroll
                for (int m = 0; m < 2; ++m)
#pragma unroll
                    for (int bj = 0; bj < 2; ++bj) {
                        const size_t o = (size_t)(rbase + ai * 128 + (mh + m) * 16) * D + cbase + bj * 128;
                        const f32x4 v0 = acc[ai][bj][mh + m][0], v1 = acc[ai][bj][mh + m][1];
                        const u32x4 ya = a[m][bj], y2 = b[m][bj]; u32x4 w;
                        if (kind == K_GA) {
                            w.x = pk2(sigmoidf_(v0[0]) * bflo(ya.x), sigmoidf_(v0[1]) * bfhi(ya.x)); w.y = pk2(sigmoidf_(v0[2]) * bflo(ya.y), sigmoidf_(v0[3]) * bfhi(ya.y));
                            w.z = pk2(sigmoidf_(v1[0]) * bflo(ya.z), sigmoidf_(v1[1]) * bfhi(ya.z)); w.w = pk2(sigmoidf_(v1[2]) * bflo(ya.w), sigmoidf_(v1[3]) * bfhi(ya.w));
                        } else {
                            w.x = pk2(bflo(ya.x) + sigmoidf_(v0[0]) * bflo(y2.x), bfhi(ya.x) + sigmoidf_(v0[1]) * bfhi(y2.x));
                            w.y = pk2(bflo(ya.y) + sigmoidf_(v0[2]) * bflo(y2.y), bfhi(ya.y) + sigmoidf_(v0[3]) * bfhi(y2.y));
                            w.z = pk2(bflo(ya.z) + sigmoidf_(v1[0]) * bflo(y2.z), bfhi(ya.z) + sigmoidf_(v1[1]) * bfhi(y2.z));
                            w.w = pk2(bflo(ya.w) + sigmoidf_(v1[2]) * bflo(y2.w), bfhi(ya.w) + sigmoidf_(v1[3]) * bfhi(y2.w));
                        }
                        *(u32x4*)(ym + o) = w;
                    }
            }
        } else if (kind == K_SGT) {
            bf16* sg = (bf16*)(ws + WS_HALO) - (size_t)MPROMPT * D;
#pragma unroll
            for (int ai = 0; ai < 2; ++ai)
#pragma unroll
                for (int m = 0; m < 4; ++m)
#pragma unroll
                    for (int bj = 0; bj < 2; ++bj) {
                        f32x4 v0 = acc[ai][bj][m][0], v1 = acc[ai][bj][m][1];
#pragma unroll
                        for (int e = 0; e < 4; ++e) { v0[e] = sigmoidf_(v0[e]); v1[e] = sigmoidf_(v1[e]); }
                        u32x4 w; EPI_PACK(w, v0, v1);
                        *(u32x4*)(sg + (size_t)(rbase + ai * 128 + m * 16) * D + cbase + bj * 128) = w;
                    }
        } else if (kind == K_YBS) {
            const bf16* sg = (const bf16*)(ws + WS_HALO) - (size_t)MPROMPT * D;
            bf16* part = (bf16*)(ws + WS_R1) + ((size_t)u.aux * 2048 - MPROMPT) * D;
#pragma unroll
            for (int ai = 0; ai < 2; ++ai) {
                u32x4 g[4][2];
#pragma unroll
                for (int m = 0; m < 4; ++m)
#pragma unroll
                    for (int bj = 0; bj < 2; ++bj) g[m][bj] = *(const u32x4*)(sg + (size_t)(rbase + ai * 128 + m * 16) * D + cbase + bj * 128);
#pragma unroll
                for (int m = 0; m < 4; ++m)
#pragma unroll
                    for (int bj = 0; bj < 2; ++bj) {
                        const f32x4 a0 = acc[ai][bj][m][0], a1 = acc[ai][bj][m][1]; const u32x4 gg = g[m][bj];
                        u32x4 w; w.x = pk2(bflo(gg.x) * a0[0], bfhi(gg.x) * a0[1]); w.y = pk2(bflo(gg.y) * a0[2], bfhi(gg.y) * a0[3]);
                        w.z = pk2(bflo(gg.z) * a1[0], bfhi(gg.z) * a1[1]); w.w = pk2(bflo(gg.w) * a1[2], bfhi(gg.w) * a1[3]);
                        *(u32x4*)(part + (size_t)(rbase + ai * 128 + m * 16) * D + cbase + bj * 128) = w;
                    }
            }
        } else if (kind == K_OS || kind == K_FF2S) {
            const float* modp = (const float*)(ws + WS_MOD);
            bf16* part = (bf16*)(ws + (kind == K_OS ? WS_R1 : WS_XN)) + ((size_t)u.aux * 2048 - MPROMPT) * D;
#pragma unroll
            for (int ai = 0; ai < 2; ++ai) {
                const int r0 = rbase + ai * 128;
                const float* gt = modp + (size_t)batch_of(r0) * 6144 + (kind == K_OS ? 2048 : 5120) + cbase;
#pragma unroll
                for (int bj = 0; bj < 2; ++bj) {
                    const f32x4 g0 = *(const f32x4*)(gt + bj * 128), g1 = *(const f32x4*)(gt + bj * 128 + 4);
#pragma unroll
                    for (int m = 0; m < 4; ++m) {
                        const f32x4 v0 = g0 * acc[ai][bj][m][0], v1 = g1 * acc[ai][bj][m][1];
                        u32x4 w; EPI_PACK(w, v0, v1);
                        *(u32x4*)(part + (size_t)(r0 + m * 16) * D + cbase + bj * 128) = w;
                    }
                }
            }
        } else {
            const float* modp = (const float*)(ws + WS_MOD);
#pragma unroll
            for (int am = 0; am < 4; ++am) {
                const int ai = am >> 1, mh = (am & 1) * 2;
                const int r0 = rbase + ai * 128 + mh * 16;
                const float* gt = modp + (size_t)batch_of(r0) * 6144 + (kind == K_O ? 2048 : 5120) + cbase;
                f32x4 g[2][2], x[2][2][2];
#pragma unroll
                for (int bj = 0; bj < 2; ++bj) { g[bj][0] = *(const f32x4*)(gt + bj * 128); g[bj][1] = *(const f32x4*)(gt + bj * 128 + 4); }
#pragma unroll
                for (int m = 0; m < 2; ++m) {
                    const int r = r0 + m * 16;
                    const float* xr = (kind == K_O) ? ((r < MPROMPT ? P->x_prompt + (size_t)r * D : P->x_sample + (size_t)(r - MPROMPT) * D) + cbase) : (P->out + (size_t)r * D + cbase);
#pragma unroll
                    for (int bj = 0; bj < 2; ++bj) { x[m][bj][0] = *(const f32x4*)(xr + bj * 128); x[m][bj][1] = *(const f32x4*)(xr + bj * 128 + 4); }
                }
#pragma unroll
                for (int m = 0; m < 2; ++m) {
                    float* dst = P->out + (size_t)(r0 + m * 16) * D + cbase;
#pragma unroll
                    for (int bj = 0; bj < 2; ++bj) {
                        *(f32x4*)(dst + bj * 128) = x[m][bj][0] + g[bj][0] * acc[ai][bj][mh + m][0];
                        *(f32x4*)(dst + bj * 128 + 4) = x[m][bj][1] + g[bj][1] * acc[ai][bj][mh + m][1];
                    }
                }
            }
        }
#undef EPI_PACK
    }
};

struct SchedFlat {
    const bf16 *A0, *A1, *A2; const bf16 *B0, *B1, *B2; int n0, n1, n2, k0, k1, k2; int nN, G, c, K;
    __device__ __forceinline__ bool next(int i, pg8::Unit& u) const {
        const long L = (long)i * G + c; if (L >= (long)72 * nN) return false;
        int pm, pg; pg8::decode_tile((int)L, 72, nN, pm, pg);
        const bf16* A; const bf16* B; int kind, pn;
        if (pg < n0) { A = A0; B = B0; kind = k0; pn = pg; }
        else if (pg < n0 + n1) { A = A1; B = B1; kind = k1; pn = pg - n0; }
        else { A = A2; B = B2; kind = k2; pn = pg - n0 - n1; }
        u.pm = pm; u.pn = pn; u.kind = kind; u.aux = 0;
        u.A = (const char*)A + (size_t)pm * 256 * K * 2; u.Bt = (const char*)B + (size_t)pn * 256 * K * 2;
        return true;
    }
};
struct SchedPair {
    const bf16 *A0, *A1; const bf16 *B0, *B1; int k0, k1; int G, c, K;
    __device__ __forceinline__ bool next(int i, pg8::Unit& u) const {
        const int j = i >> 1, half = i & 1; const long L = (long)j * G + c; if (L >= 288) return false;
        int pm, pn; pg8::decode_tile((int)L, 72, 4, pm, pn);
        u.pm = pm; u.pn = pn; u.kind = half ? k1 : k0; u.aux = 0;
        u.A = (const char*)(half ? A1 : A0) + (size_t)pm * 256 * K * 2; u.Bt = (const char*)(half ? B1 : B0) + (size_t)pn * 256 * K * 2;
        return true;
    }
};

struct SchedP2 {
    const bf16 *XNp, *Bp, *Bz; int c;
    __device__ __forceinline__ bool next(int i, pg8::Unit& u) const {
        const int L = i * 256 + c; if (L >= 1024) return false;
        int pm, pn; const bf16* B;
        if (L < 864) { pg8::decode_tile(L, 72, 12, pm, pn); u.kind = K_PA; B = Bp; } else { pg8::decode_tile(L - 864, 72, 4, pm, pn); u.kind = K_Z; B = Bz; }
        u.pm = pm; u.pn = pn; u.aux = 0;
        u.A = (const char*)XNp + (size_t)pm * 256 * D * 2; u.Bt = (const char*)B + (size_t)pn * 256 * D * 2;
        return true;
    }
};
struct SchedP4 {
    const bf16 *XNp, *Bqkv, *Bab, *YAp, *Bya; int c;
    __device__ __forceinline__ bool next(int i, pg8::Unit& u) const {
        const int L = i * 256 + c; if (L >= 1224) return false;
        u.aux = 0;
        if (L < 936) {
            int pm, pg; pg8::decode_tile(L, 72, 13, pm, pg);
            u.pm = pm; u.A = (const char*)XNp + (size_t)pm * 256 * D * 2;
            if (pg < 12) { u.pn = pg; u.kind = K_PQ; u.Bt = (const char*)Bqkv + (size_t)pg * 256 * D * 2; } else { u.pn = 0; u.kind = K_AB; u.Bt = (const char*)Bab; }
        } else {
            int pm, pn; pg8::decode_tile(L - 936, 72, 4, pm, pn);
            u.pm = pm; u.pn = pn; u.kind = K_YA;
            u.A = (const char*)YAp + (size_t)pm * 256 * D * 2; u.Bt = (const char*)Bya + (size_t)pn * 256 * D * 2;
        }
        return true;
    }
};
struct SchedScanG {
    const bf16 *XNp, *Bz, *Bgb, *Bga; int c;
    __device__ __forceinline__ bool next(int i, pg8::Unit& u) const {
        const int L = i * 128 + c; if (L >= 448) return false;
        int pm, pn; const bf16* B;
        if (L < 128) { pg8::decode_tile(160 + L, 72, 4, pm, pn); u.kind = K_Z; B = Bz; }
        else if (L < 160) { const int t = L - 128; pm = 64 + (t >> 2); pn = t & 3; u.kind = K_SGT; B = Bgb; }
        else { pg8::decode_tile(L - 160, 72, 4, pm, pn); u.kind = K_GA; B = Bga; }
        u.pm = pm; u.pn = pn; u.aux = 0;
        u.A = (const char*)XNp + (size_t)pm * 256 * D * 2; u.Bt = (const char*)B + (size_t)pn * 256 * D * 2;
        return true;
    }
};
struct SchedPair64 {
    const bf16 *A0, *A1; const bf16 *B0, *B1; int k0, k1; int G, c;
    __device__ __forceinline__ bool next(int i, pg8::Unit& u) const {
        const int j = i >> 1, half = i & 1; const long L = (long)j * G + c; if (L >= 256) return false;
        int pm, pn; pg8::decode_tile((int)L, 64, 4, pm, pn);
        u.pm = pm; u.pn = pn; u.kind = half ? k1 : k0; u.aux = 0;
        u.A = (const char*)(half ? A1 : A0) + (size_t)pm * 256 * D * 2; u.Bt = (const char*)(half ? B1 : B0) + (size_t)pn * 256 * D * 2;
        return true;
    }
};
struct SchedFull64 {
    const bf16 *A, *B; int kind, G, c, ld;
    __device__ __forceinline__ bool next(int i, pg8::Unit& u) const {
        const long L = (long)i * G + c; if (L >= 256) return false;
        int pm, pn; pg8::decode_tile((int)L, 64, 4, pm, pn);
        u.pm = pm; u.pn = pn; u.kind = kind; u.aux = 0;
        u.A = (const char*)A + (size_t)pm * 256 * ld * 2; u.Bt = (const char*)B + (size_t)pn * 256 * ld * 2;
        return true;
    }
};
struct SchedSlice {
    const bf16 *A, *B; int kind, G, c, ld, ks;
    __device__ __forceinline__ bool next(int i, pg8::Unit& u) const {
        const long L = (long)i * G + c; if (L >= 256) return false;
        const int tile = (int)L >> 3, sl = (int)L & 7;
        u.pm = 64 + (tile >> 2); u.pn = tile & 3; u.kind = kind; u.aux = sl;
        u.A = (const char*)A + ((size_t)u.pm * 256 * ld + (size_t)sl * ks) * 2; u.Bt = (const char*)B + ((size_t)u.pn * 256 * ld + (size_t)sl * ks) * 2;
        return true;
    }
};

struct TrItem { const float* W; bf16* WT; int ldw, K, src0, dst0, kb, nb, dnb; };
__device__ __forceinline__ void transpose_load(const TrItem& t, f32x4 (&v)[8], int lane) {
    const int kk = lane >> 3, c4 = (lane & 7) * 4;
#pragma unroll
    for (int i = 0; i < 8; ++i) v[i] = *(const f32x4*)(t.W + (size_t)(64 * t.kb + 8 * i + kk) * t.ldw + t.src0 + 32 * t.nb + c4);
}
__device__ __forceinline__ void transpose_finish(const TrItem& t, const f32x4 (&v)[8], LAS float* scr, int lane) {
    const int kk = lane >> 3, c4 = (lane & 7) * 4;
#pragma unroll
    for (int i = 0; i < 8; ++i) { LAS float* d = scr + (8 * i + kk) * 33 + c4; d[0] = v[i].x; d[1] = v[i].y; d[2] = v[i].z; d[3] = v[i].w; }
    LDS_WAIT();
    const int c = lane & 7;
#pragma unroll
    for (int j = 0; j < 4; ++j) { const int n = (lane >> 3) + 8 * j; const LAS float* s = scr + (8 * c) * 33 + n;
        u32x4 o; o.x = pk2(s[0 * 33], s[1 * 33]); o.y = pk2(s[2 * 33], s[3 * 33]); o.z = pk2(s[4 * 33], s[5 * 33]); o.w = pk2(s[6 * 33], s[7 * 33]);
        *(u32x4*)(t.WT + (size_t)(t.dst0 + 32 * t.dnb + n) * t.K + 64 * t.kb + 8 * c) = o; }
    LDS_WAIT();
}
__device__ __forceinline__ TrItem tr_decode0(const KP P, unsigned char* ws, int r) {
    constexpr int I0 = 16 * 224, I1 = 16 * 64, I2 = 16 * 32;
    TrItem t; t.K = D;
    if (r < I0) { t.W = P->w_in; t.ldw = 9232; t.src0 = 0; t.WT = (bf16*)(ws + WS_WIN); t.dst0 = 0; t.kb = r / 224; t.nb = r % 224;
        t.dnb = t.nb; if (t.nb >= 32 && t.nb < 64) t.dnb = 32 + 8 * ((t.nb - 32) >> 2) + ((t.nb - 32) & 3); else if (t.nb >= 64 && t.nb < 96) t.dnb = 32 + 8 * ((t.nb - 64) >> 2) + 4 + ((t.nb - 64) & 3);
        return t; } r -= I0;
    if (r < I1) { t.W = P->w_in; t.ldw = 9232; t.src0 = 7184; t.WT = (bf16*)(ws + WS_WIN); t.dst0 = 7168; t.kb = r / 64; t.nb = r % 64; t.dnb = t.nb; return t; } r -= I1;
    t.ldw = D; t.src0 = 0; t.dst0 = 0;
    if (r < I2) { t.W = P->w_a_out; t.WT = (bf16*)(ws + WS_WA); } else if (r < 2 * I2) { t.W = P->w_b_out; t.WT = (bf16*)(ws + WS_WB); r -= I2; } else { t.W = P->w_o; t.WT = (bf16*)(ws + WS_WO); r -= 2 * I2; }
    t.kb = r / 32; t.nb = r % 32; t.dnb = t.nb; return t;
}
__device__ __forceinline__ TrItem tr_decode1(const KP P, unsigned char* ws, int r) {
    TrItem t; t.src0 = 0; t.dst0 = 0;
    if (r < 2048) { t.W = P->w_ff1; t.ldw = FF; t.K = D; t.WT = (bf16*)(ws + WS_WFF1); t.kb = r / 128; t.nb = r % 128; }
    else { r -= 2048; t.W = P->w_ff2; t.ldw = D; t.K = FF; t.WT = (bf16*)(ws + WS_WFF2); t.kb = r / 32; t.nb = r % 32; }
    t.dnb = t.nb; return t;
}

template <int MODE>
__device__ __forceinline__ void norm_phase(const KP P, unsigned char* ws, int gw, int NGW, int lane) {
    const float* g = MODE == 0 ? P->norm1_g : (MODE == 1 ? P->norm2_g : P->final_norm_g);
    const float* modb = (const float*)(ws + (MODE == 2 ? WS_MODF : WS_MOD));
    const int mstride = MODE == 2 ? 2048 : 6144, sco = MODE == 0 ? 1024 : (MODE == 1 ? 4096 : 1024), sho = MODE == 0 ? 0 : (MODE == 1 ? 3072 : 0);
    const float* xp = P->x_prompt; const float* xs = P->x_sample; float* outp = P->out;
    const bf16* part = (const bf16*)(ws + (MODE == 1 ? WS_R1 : WS_XN));
    bf16* xn = (bf16*)(ws + WS_XN);
#define NORM_BODY(v, r) do { \
        const float* mb = modb + (size_t)batch_of(r) * mstride; \
        f32x4 gg[4], ss[4], hh[4]; \
        _Pragma("unroll") for (int j = 0; j < 4; ++j) { const int c = lane * 4 + 256 * j; gg[j] = *(const f32x4*)(g + c); ss[j] = *(const f32x4*)(mb + sco + c); hh[j] = *(const f32x4*)(mb + sho + c); } \
        float s = 0.f; \
        _Pragma("unroll") for (int j = 0; j < 4; ++j) s += (v[j].x * v[j].x + v[j].y * v[j].y) + (v[j].z * v[j].z + v[j].w * v[j].w); \
        const float rstd = 1.f / sqrtf(wave_sum(s) * (1.f / D) + EPS); \
        _Pragma("unroll") for (int j = 0; j < 4; ++j) { \
            const int c = lane * 4 + 256 * j; \
            const f32x4 o = (v[j] * rstd) * gg[j] * (ss[j] + 1.f) + hh[j]; \
            if (MODE == 2) *(f32x4*)(outp + (size_t)(r) * D + c) = o; \
            else { u32x2 w; w.x = pk2(o.x, o.y); w.y = pk2(o.z, o.w); *(u32x2*)(xn + (size_t)(r) * D + c) = w; } \
        } } while (0)
    const float* src = MODE == 0 ? xp : outp;
    int r = gw; f32x4 nv[2][4];
#pragma unroll
    for (int u = 0; u < 2; ++u) if (r + u * NGW < MPROMPT) {
#pragma unroll
        for (int j = 0; j < 4; ++j) nv[u][j] = *(const f32x4*)(src + (size_t)(r + u * NGW) * D + lane * 4 + 256 * j); }
    for (; r < MPROMPT; r += 2 * NGW) {
        f32x4 v0[4], v1[4];
#pragma unroll
        for (int j = 0; j < 4; ++j) { v0[j] = nv[0][j]; v1[j] = nv[1][j]; }
#pragma unroll
        for (int u = 0; u < 2; ++u) { const int rn = r + (2 + u) * NGW; if (rn < MPROMPT) {
#pragma unroll
            for (int j = 0; j < 4; ++j) nv[u][j] = *(const f32x4*)(src + (size_t)rn * D + lane * 4 + 256 * j); } }
        NORM_BODY(v0, r);
        if (r + NGW < MPROMPT) { const int r1 = r + NGW; NORM_BODY(v1, r1); }
    }
    for (r = MPROMPT + gw; r < MTOK; r += NGW) {
        f32x4 v[4];
        const float* xr = MODE == 2 ? outp + (size_t)r * D : xs + (size_t)(r - MPROMPT) * D;
#pragma unroll
        for (int j = 0; j < 4; ++j) v[j] = *(const f32x4*)(xr + lane * 4 + 256 * j);
        if (MODE != 0) {
            u32x2 pw[8][4];
#pragma unroll
            for (int sl = 0; sl < 8; ++sl)
#pragma unroll
                for (int j = 0; j < 4; ++j) pw[sl][j] = *(const u32x2*)(part + ((size_t)sl * 2048 + (r - MPROMPT)) * D + lane * 4 + 256 * j);
#pragma unroll
            for (int sl = 0; sl < 8; ++sl)
#pragma unroll
                for (int j = 0; j < 4; ++j) { v[j].x += bflo(pw[sl][j].x); v[j].y += bfhi(pw[sl][j].x); v[j].z += bflo(pw[sl][j].y); v[j].w += bfhi(pw[sl][j].y); }
            if (MODE == 1) {
#pragma unroll
                for (int j = 0; j < 4; ++j) *(f32x4*)(outp + (size_t)r * D + lane * 4 + 256 * j) = v[j];
            }
        }
        NORM_BODY(v, r);
    }
#undef NORM_BODY
}

__global__ void __launch_bounds__(512, 2) mega_fwd(Params p) {
    extern __shared__ __attribute__((aligned(16))) unsigned char smem[];
    LAS unsigned char* lds = (LAS unsigned char*)smem;
    cg::grid_group grid = cg::this_grid();
    volatile LAS unsigned* xst = (volatile LAS unsigned*)(lds + LDS_BYTES - 16);
    if (threadIdx.x < 4) xst[threadIdx.x] = 0u;
    __syncthreads();
    const XcdBarrier xbar = xcd_barrier_post((unsigned*)(p.ws + WS_BAR), xst);
    if (gridDim.x == 0x7fffffffu) grid.sync();
#define PHASE_BEGIN const KP P = kp_get(); unsigned char* const ws = P->ws; (void)ws; \
    int tid = threadIdx.x; asm volatile("" : "+v"(tid)); const int lane = tid & 63, wave = __builtin_amdgcn_readfirstlane(tid >> 6); \
    int bid = blockIdx.x; asm volatile("" : "+s"(bid)); const int G = gridDim.x; const int gw = bid * 8 + wave, NGW = G * 8; (void)lane; (void)gw; (void)NGW;
#define mod ((float*)(ws + WS_MOD))
#define modf ((float*)(ws + WS_MODF))
#define XN ((bf16*)(ws + WS_XN))
#define R1 ((bf16*)(ws + WS_R1))
#define R2 ((bf16*)(ws + WS_R2))
#define R3 ((bf16*)(ws + WS_R3))
#define WIN ((bf16*)(ws + WS_WIN))
#define WA ((bf16*)(ws + WS_WA))
#define WB ((bf16*)(ws + WS_WB))
#define WO ((bf16*)(ws + WS_WO))
#define WFF1 ((bf16*)(ws + WS_WFF1))
#define WFF2 ((bf16*)(ws + WS_WFF2))
#define GLOG ((float*)(ws + WS_G))
#define BETA ((float*)(ws + WS_BETA))
#define GC ((float*)(ws + WS_GC))
#define HALO ((bf16*)(ws + WS_HALO))
#define ZB ((bf16*)P->out)
#define OB ((bf16*)((unsigned char*)P->out + 36 * MiB))
    const Epi E{};

    {
        PHASE_BEGIN
        LAS bf16* cs = (LAS bf16*)lds;
        for (int i = tid; i < NB * D / 4; i += 512) { const int r = i >> 8, k = (i & 255) * 4; const f32x4 c = *(const f32x4*)(r < 4 ? P->c_prompt + r * D + k : P->c_sample + (r - 4) * D + k);
            u32x2 w; w.x = pk2(c.x * __builtin_amdgcn_rcpf(1.f + __expf(-c.x)), c.y * __builtin_amdgcn_rcpf(1.f + __expf(-c.y))); w.y = pk2(c.z * __builtin_amdgcn_rcpf(1.f + __expf(-c.z)), c.w * __builtin_amdgcn_rcpf(1.f + __expf(-c.w)));
            *(LAS u32x2*)(cs + r * 1032 + k) = w; }
        __syncthreads();
        LAS float* scr = (LAS float*)(lds + 74304 + wave * 8448);
        {
            const int cg = 2 * bid + (wave >> 2), kq = wave & 3;
            int col0 = cg * 16; const float* W; const float* bias; float* outp; int ld;
            if (col0 < 6144) { W = P->ada_w; bias = P->ada_b; outp = mod; ld = 6144; } else { col0 -= 6144; W = P->final_ada_w; bias = P->final_ada_b; outp = modf; ld = 2048; }
            const int n = lane & 15, q = lane >> 4;
            f32x4 acc[3] = {{0.f, 0.f, 0.f, 0.f}, {0.f, 0.f, 0.f, 0.f}, {0.f, 0.f, 0.f, 0.f}};
            if (cg < 512) {
#pragma unroll 4
                for (int ks = 8 * kq; ks < 8 * kq + 8; ++ks) {
                    const float* wp = W + (size_t)(32 * ks + 8 * q) * ld + col0 + n;
                    float wv[8];
#pragma unroll
                    for (int j = 0; j < 8; ++j) wv[j] = wp[(size_t)j * ld];
                    u32x4 bw; bw.x = pk2(wv[0], wv[1]); bw.y = pk2(wv[2], wv[3]); bw.z = pk2(wv[4], wv[5]); bw.w = pk2(wv[6], wv[7]);
                    const bf16x8 bfrag = __builtin_bit_cast(bf16x8, bw);
#pragma unroll
                    for (int mt = 0; mt < 3; ++mt) {
                        const int row = 16 * mt + n;
                        bf16x8 afrag = {0, 0, 0, 0, 0, 0, 0, 0};
                        if (row < NB) afrag = *(const LAS bf16x8*)(cs + row * 1032 + 32 * ks + 8 * q);
                        acc[mt] = __builtin_amdgcn_mfma_f32_16x16x32_bf16(afrag, bfrag, acc[mt], 0, 0, 0);
                    }
                }
            }
#pragma unroll
            for (int mt = 0; mt < 3; ++mt) *(LAS f32x4*)(scr + (mt * 64 + lane) * 4) = acc[mt];
            __syncthreads();
            if (kq == 0 && cg < 512) {
                const float bv = bias[col0 + n];
#pragma unroll
                for (int mt = 0; mt < 3; ++mt) {
                    f32x4 t = acc[mt];
#pragma unroll
                    for (int w2 = 1; w2 < 4; ++w2) t += *(const LAS f32x4*)((LAS float*)(lds + 74304 + (wave + w2) * 8448) + (mt * 64 + lane) * 4);
#pragma unroll
                    for (int jj = 0; jj < 4; ++jj) { const int row = 16 * mt + 4 * q + jj; if (row < NB) outp[(size_t)row * ld + col0 + n] = t[jj] + bv; }
                }
            }
            __syncthreads();
        }
        constexpr int NT = 16 * 224 + 16 * 64 + 3 * 16 * 32;
        for (int base = gw; base < NT; base += 3 * NGW) {
            TrItem t0 = tr_decode0(P, ws, base), t1 = t0, t2 = t0; f32x4 v0[8], v1[8], v2[8];
            const bool h1 = base + NGW < NT, h2 = base + 2 * NGW < NT;
            transpose_load(t0, v0, lane);
            if (h1) { t1 = tr_decode0(P, ws, base + NGW); transpose_load(t1, v1, lane); }
            if (h2) { t2 = tr_decode0(P, ws, base + 2 * NGW); transpose_load(t2, v2, lane); }
            transpose_finish(t0, v0, scr, lane);
            if (h1) transpose_finish(t1, v1, scr, lane);
            if (h2) transpose_finish(t2, v2, scr, lane);
        }
        if (gw == NGW - 1) {
            for (int e = lane; e < 16 * D; e += 64) { const int n = e >> 10, k = e & 1023; WIN[(size_t)(9216 + n) * D + k] = (bf16)f2bf(P->w_in[(size_t)k * 9232 + 7168 + n]); }
        }
    }
    xcd_barrier(xbar);

    { PHASE_BEGIN
      norm_phase<0>(P, ws, gw, NGW, lane); }
    xcd_barrier(xbar);

    {
        PHASE_BEGIN
        SchedP2 S; S.XNp = XN; S.Bp = WIN; S.Bz = WIN + (size_t)6144 * D; S.c = bid;
        pg8::gemm_phase(lds, D, D, S, E);
    }
    xcd_barrier(xbar);

    { PHASE_BEGIN
    for (int idx = bid * 512 + tid; idx < MTOK * 128; idx += G * 512) {
        const int r = idx >> 7, c8 = (idx & 127) * 8;
        const bool prm = r < MPROMPT; const int tpos = prm ? (r & 4095) : ((r - MPROMPT) & 63); const int T = prm ? 4096 : 64; const int bs = prm ? (r >> 12) : ((r - MPROMPT) >> 6);
        const bf16* row = R1 + (size_t)r * 3072 + c8;
        const u32x4 pb = *(const u32x4*)row, uv0 = *(const u32x4*)(row + 1024);
        float u0[8], u1[8], u2[8];
#define P3_UNPK(U_, W_) do { U_[0] = bflo(W_.x); U_[1] = bfhi(W_.x); U_[2] = bflo(W_.y); U_[3] = bfhi(W_.y); U_[4] = bflo(W_.z); U_[5] = bfhi(W_.z); U_[6] = bflo(W_.w); U_[7] = bfhi(W_.w); } while (0)
        P3_UNPK(u0, uv0);
        if (tpos >= 1) { const u32x4 w1 = *(const u32x4*)(row - 3072 + 1024); P3_UNPK(u1, w1); }
        else {
#pragma unroll
            for (int e = 0; e < 8; ++e) u1[e] = prm ? 0.f : P->cache_conv_a[((size_t)bs * 2 + 1) * D + c8 + e];
        }
        if (tpos >= 2) { const u32x4 w2 = *(const u32x4*)(row - 6144 + 1024); P3_UNPK(u2, w2); }
        else {
#pragma unroll
            for (int e = 0; e < 8; ++e) u2[e] = prm ? 0.f : P->cache_conv_a[((size_t)bs * 2 + tpos) * D + c8 + e];
        }
#undef P3_UNPK
        float y[8];
#pragma unroll
        for (int e = 0; e < 8; ++e) y[e] = P->conv_a_w[c8 + e] * u2[e] + P->conv_a_w[D + c8 + e] * u1[e] + P->conv_a_w[2 * D + c8 + e] * u0[e];
        u32x4 o; o.x = pk2(bflo(pb.x) * y[0], bfhi(pb.x) * y[1]); o.y = pk2(bflo(pb.y) * y[2], bfhi(pb.y) * y[3]);
        o.z = pk2(bflo(pb.z) * y[4], bfhi(pb.z) * y[5]); o.w = pk2(bflo(pb.w) * y[6], bfhi(pb.w) * y[7]);
        *(u32x4*)(R2 + (size_t)r * D + c8) = o;
        if (tpos >= T - 2) {
            float* dst = P->out + (prm ? O_CONVA_P : O_CONVA_S) + ((size_t)bs * 2 + (tpos - (T - 2))) * D + c8;
            *(f32x4*)dst = (f32x4){u0[0], u0[1], u0[2], u0[3]}; *(f32x4*)(dst + 4) = (f32x4){u0[4], u0[5], u0[6], u0[7]};
        }
    } }
    xcd_barrier(xbar);

    {
        PHASE_BEGIN
        SchedP4 S; S.XNp = XN; S.Bqkv = WIN + (size_t)3072 * D; S.Bab = WIN + (size_t)9216 * D; S.YAp = R2; S.Bya = WA; S.c = bid;
        pg8::gemm_phase(lds, D, D, S, E);
    }
    xcd_barrier(xbar);

    { PHASE_BEGIN
    for (int it = gw; it < NCHUNK * 24; it += NGW) {
        const int cidx = it / 24, s = it % 24, part = s >> 3;
        const int col = s * 128 + 2 * lane;
        const bool prm = cidx < 256; const int bs = prm ? (cidx >> 6) : (cidx - 256);
        const bool first = prm ? ((cidx & 63) == 0) : true; const bool lastc = prm ? ((cidx & 63) == 63) : true;
        float xa[3], xb[3];
#pragma unroll
        for (int j = 0; j < 3; ++j) {
            if (!first) { const unsigned w = *(const unsigned*)(HALO + ((size_t)(cidx - 1) * 3 + j) * 3072 + col); xa[j] = bflo(w); xb[j] = bfhi(w); }
            else if (prm) { xa[j] = 0.f; xb[j] = 0.f; }
            else { const float* cp = P->cache_conv_qkv + ((size_t)bs * 3 + j) * 3072 + col; xa[j] = cp[0]; xb[j] = cp[1]; }
        }
        float wa[4], wb[4];
#pragma unroll
        for (int j = 0; j < 4; ++j) { wa[j] = P->conv_qkv_w[(size_t)j * 3072 + col]; wb[j] = P->conv_qkv_w[(size_t)j * 3072 + col + 1]; }
        bf16* base = R1 + (size_t)cidx * 64 * 3072 + col;
        const float qs = part == 0 ? 0.08838834764831845f : 1.f;
#pragma unroll
        for (int hb = 0; hb < 2; ++hb) {
            unsigned xv[32];
#pragma unroll
            for (int t = 0; t < 32; ++t) xv[t] = *(const unsigned*)(base + (size_t)(hb * 32 + t) * 3072);
#pragma unroll
            for (int t = 0; t < 32; ++t) {
                const float x0 = bflo(xv[t]), x1 = bfhi(xv[t]);
                const float y0 = wa[0] * xa[0] + wa[1] * xa[1] + wa[2] * xa[2] + wa[3] * x0;
                const float y1 = wb[0] * xb[0] + wb[1] * xb[1] + wb[2] * xb[2] + wb[3] * x1;
                xa[0] = xa[1]; xa[1] = xa[2]; xa[2] = x0; xb[0] = xb[1]; xb[1] = xb[2]; xb[2] = x1;
                float s0 = y0 * __builtin_amdgcn_rcpf(1.f + __expf(-y0)), s1 = y1 * __builtin_amdgcn_rcpf(1.f + __expf(-y1));
                if (part < 2) { const float ss = wave_sum(s0 * s0 + s1 * s1); const float sc = qs * __builtin_amdgcn_rsqf(ss + EPS); s0 *= sc; s1 *= sc; }
                *(unsigned*)(base + (size_t)(hb * 32 + t) * 3072) = pk2(s0, s1);
            }
        }
        if (lastc) {
            float* dst = P->out + (prm ? O_CONVQ_P : O_CONVQ_S) + (size_t)bs * 3 * 3072 + col;
#pragma unroll
            for (int j = 0; j < 3; ++j) { dst[(size_t)j * 3072] = xa[j]; dst[(size_t)j * 3072 + 1] = xb[j]; }
        }
    } }
    xcd_barrier(xbar);

    {
        PHASE_BEGIN
        LAS float* Am = (LAS float*)(lds + wave * 16896);
        LAS float* gcs = Am + 4096;
        LAS float* bts = gcs + 64;
        bf16* TP = R2; bf16* QKM = R2 + (size_t)NCHUNK * 8 * 4096;
        const int n = lane & 15, q = lane >> 4;
#pragma unroll 1
        for (int rnd = 0; rnd < 2; ++rnd) {
            const int it = rnd == 0 ? gw : (wave == 0 ? 2048 + bid : 1 << 30);
            if (it >= NCHUNK * 8) continue;
            const int cidx = it >> 3, h = it & 7; const int r0 = cidx * 64;
            float gv = GLOG[(size_t)(r0 + lane) * 8 + h]; const float bt = BETA[(size_t)(r0 + lane) * 8 + h];
#pragma unroll
            for (int o = 1; o < 64; o <<= 1) { const float t = __shfl_up(gv, o); if (lane >= o) gv += t; }
            gcs[lane] = gv; bts[lane] = bt; GC[(size_t)it * 64 + lane] = gv;
            LDS_WAIT();
            const bf16* qb = R1 + (size_t)r0 * 3072 + h * 128; const bf16* kb = qb + 1024;
            bf16x8 kf[4][4];
#pragma unroll
            for (int mt = 0; mt < 4; ++mt)
#pragma unroll
                for (int ks = 0; ks < 4; ++ks) kf[mt][ks] = *(const bf16x8*)(kb + (size_t)(16 * mt + n) * 3072 + 32 * ks + 8 * q);
#pragma unroll
            for (int mi = 0; mi < 4; ++mi)
#pragma unroll
                for (int nj = 0; nj < 4; ++nj) {
                    f32x4 c = {0.f, 0.f, 0.f, 0.f};
#pragma unroll
                    for (int ks = 0; ks < 4; ++ks) c = __builtin_amdgcn_mfma_f32_16x16x32_bf16(kf[mi][ks], kf[nj][ks], c, 0, 0, 0);
                    const int j = 16 * nj + n; const float gj = gcs[j];
#pragma unroll
                    for (int jj = 0; jj < 4; ++jj) { const int i = 16 * mi + 4 * q + jj; const float v = (i > j) ? bts[i] * c[jj] * __expf(gcs[i] - gj) : 0.f; Am[i * 64 + j] = v; }
                }
            {
#pragma unroll
                for (int mi = 0; mi < 4; ++mi) {
                    bf16x8 qf[4];
#pragma unroll
                    for (int ks = 0; ks < 4; ++ks) qf[ks] = *(const bf16x8*)(qb + (size_t)(16 * mi + n) * 3072 + 32 * ks + 8 * q);
#pragma unroll
                    for (int nj = 0; nj < 4; ++nj) {
                        f32x4 c = {0.f, 0.f, 0.f, 0.f};
#pragma unroll
                        for (int ks = 0; ks < 4; ++ks) c = __builtin_amdgcn_mfma_f32_16x16x32_bf16(qf[ks], kf[nj][ks], c, 0, 0, 0);
                        const int j = 16 * nj + n; const float gj = gcs[j];
#pragma unroll
                        for (int jj = 0; jj < 4; ++jj) { const int i = 16 * mi + 4 * q + jj; const float v = (i >= j) ? c[jj] * __expf(gcs[i] - gj) : 0.f; QKM[(size_t)it * 4096 + i * 64 + j] = (bf16)f2bf(v); }
                    }
                }
            }
            LDS_WAIT();
            float Tc[64];
#pragma unroll
            for (int i = 0; i < 64; ++i) {
                float s = (lane == i) ? 1.f : 0.f;
#pragma unroll
                for (int j4 = 0; j4 < (i + 3) / 4; ++j4) {
                    const f32x4 a = *(const LAS f32x4*)(Am + i * 64 + j4 * 4);
                    if (j4 * 4 + 0 < i) s -= a.x * Tc[j4 * 4 + 0];
                    if (j4 * 4 + 1 < i) s -= a.y * Tc[j4 * 4 + 1];
                    if (j4 * 4 + 2 < i) s -= a.z * Tc[j4 * 4 + 2];
                    if (j4 * 4 + 3 < i) s -= a.w * Tc[j4 * 4 + 3];
                }
                Tc[i] = s;
            }
#pragma unroll
            for (int i = 0; i < 64; ++i) TP[(size_t)it * 4096 + i * 64 + lane] = (bf16)f2bf(Tc[i] * bt);
            LDS_WAIT();
        }
    }
    xcd_barrier(xbar);

    {
        PHASE_BEGIN
        constexpr int LKG = 0, LQD = 17408, LKDT = 34816, LTP = 53248, LQK = 62464, LST = 71680, LXT = 80384, LVL = 84992, LGL = 90112;
        LAS bf16* Kg = (LAS bf16*)(lds + LKG);
        LAS bf16* Qd = (LAS bf16*)(lds + LQD);
        LAS bf16* KdT = (LAS bf16*)(lds + LKDT);
        LAS bf16* Tp = (LAS bf16*)(lds + LTP);
        LAS bf16* Qk = (LAS bf16*)(lds + LQK);
        LAS bf16* ST = (LAS bf16*)(lds + LST);
        LAS bf16* XT = (LAS bf16*)(lds + LXT);
        LAS bf16* VL = (LAS bf16*)(lds + LVL);
        LAS float* GLw = (LAS float*)(lds + LGL);
        const bf16* TPg = R2; const bf16* QKMg = R2 + (size_t)NCHUNK * 8 * 4096;
        const int n = lane & 15, q = lane >> 4, vl = 16 * (wave & 1) + n;
        const bool cw = wave < 2;
        if (cw) __builtin_amdgcn_s_setprio(3);
        const int sid = tid - 128;
        const bool two = sid < 128;
#define LBAR() do { asm volatile("s_waitcnt lgkmcnt(0)" ::: "memory"); __builtin_amdgcn_s_barrier(); asm volatile("" ::: "memory"); } while (0)
        int task, tstep;
        if (bid < 128) { task = bid; tstep = 1 << 30; } else { task = 128 + (bid - 128); tstep = G - 128; }
        for (; task < 1152; task += tstep) {
            const bool prm = task < 128; const int tt = prm ? task : task - 128;
            const int c7 = tt & 127, st = (tt & ~127) / 4 + (c7 & 7) * 4 + (c7 >> 5), vq = (c7 >> 3) & 3;
            const int b = st >> 3, h = st & 7;
            const int nch = prm ? 64 : 1; const int cidx0 = prm ? b * 64 : 256 + b;
            const int v = vq * 32 + vl;
            f32x4 Sacc[8];
            if (cw) {
#pragma unroll
                for (int kt = 0; kt < 8; ++kt) {
                    if (prm) Sacc[kt] = (f32x4){0.f, 0.f, 0.f, 0.f};
                    else {
#pragma unroll
                        for (int jj = 0; jj < 4; ++jj) Sacc[kt][jj] = P->state_delta[(((size_t)b * 8 + h) * 128 + 16 * kt + 4 * q + jj) * 128 + v];
                    }
                    u32x2 w; w.x = pk2(Sacc[kt][0], Sacc[kt][1]); w.y = pk2(Sacc[kt][2], Sacc[kt][3]);
                    *(LAS u32x2*)(ST + vl * 136 + 16 * kt + 4 * q) = w;
                }
            }
            u32x4 pq0[2], pq1[2], ptp[2], pqk[2], pvv; unsigned pkw[2][8]; float pgt[2], pgl;
#define SCAN_PREFETCH(cidx_) do { const int r0_ = (cidx_) * 64; const size_t ci_ = (size_t)(cidx_) * 8 + h; \
            _Pragma("unroll") for (int p_ = 0; p_ < 2; ++p_) if (p_ == 0 || two) { const int it_ = sid + 384 * p_, t_ = it_ >> 3, kg_ = it_ & 7; \
                const bf16* qrow_ = R1 + (size_t)(r0_ + t_) * 3072 + h * 128; \
                pq0[p_] = *(const u32x4*)(qrow_ + kg_ * 16); pq1[p_] = *(const u32x4*)(qrow_ + kg_ * 16 + 8); \
                _Pragma("unroll") for (int e_ = 0; e_ < 8; ++e_) pkw[p_][e_] = *(const unsigned*)(qrow_ + 1024 + 2 * kg_ + 16 * e_); \
                ptp[p_] = *(const u32x4*)(TPg + ci_ * 4096 + t_ * 64 + kg_ * 8); pqk[p_] = *(const u32x4*)(QKMg + ci_ * 4096 + t_ * 64 + kg_ * 8); \
                pgt[p_] = GC[ci_ * 64 + t_]; } \
            pgl = GC[ci_ * 64 + 63]; \
            if (sid < 256) pvv = *(const u32x4*)(R1 + (size_t)(r0_ + (sid >> 2)) * 3072 + 2048 + h * 128 + vq * 32 + (sid & 3) * 8); } while (0)
            if (!cw) SCAN_PREFETCH(cidx0);
            for (int ch = 0; ch < nch; ++ch) {
                const int cidx = cidx0 + ch; const int r0 = cidx * 64;
                LBAR();
                if (!cw) {
#pragma unroll
                    for (int p = 0; p < 2; ++p) if (p == 0 || two) {
                        const int it = sid + 384 * p, t = it >> 3, kg = it & 7;
                        const float eg = __expf(pgt[p]), ed = __expf(pgl - pgt[p]);
                        u32x4 o;
                        o.x = pk2(bflo(pq0[p].x) * eg, bfhi(pq0[p].x) * eg); o.y = pk2(bflo(pq0[p].y) * eg, bfhi(pq0[p].y) * eg); o.z = pk2(bflo(pq0[p].z) * eg, bfhi(pq0[p].z) * eg); o.w = pk2(bflo(pq0[p].w) * eg, bfhi(pq0[p].w) * eg);
                        *(LAS u32x4*)(Qd + t * 136 + kg * 16) = o;
                        o.x = pk2(bflo(pq1[p].x) * eg, bfhi(pq1[p].x) * eg); o.y = pk2(bflo(pq1[p].y) * eg, bfhi(pq1[p].y) * eg); o.z = pk2(bflo(pq1[p].z) * eg, bfhi(pq1[p].z) * eg); o.w = pk2(bflo(pq1[p].w) * eg, bfhi(pq1[p].w) * eg);
                        *(LAS u32x4*)(Qd + t * 136 + kg * 16 + 8) = o;
#pragma unroll
                        for (int e = 0; e < 8; ++e) {
                            const int k = 2 * kg + 16 * e; const float lo = bflo(pkw[p][e]), hi = bfhi(pkw[p][e]);
                            *(LAS unsigned*)(Kg + t * 136 + k) = pk2(lo * eg, hi * eg);
                            KdT[k * 72 + t] = (bf16)f2bf(lo * ed); KdT[(k + 1) * 72 + t] = (bf16)f2bf(hi * ed);
                        }
                        *(LAS u32x4*)(Tp + t * 72 + kg * 8) = ptp[p];
                        *(LAS u32x4*)(Qk + t * 72 + kg * 8) = pqk[p];
                    }
                    if (sid < 256) *(LAS u32x4*)(VL + (sid >> 2) * 40 + (sid & 3) * 8) = pvv;
                    if (sid == 0) GLw[0] = __expf(pgl);
                }
                LBAR();
                if (!cw) { if (ch + 1 < nch) SCAN_PREFETCH(cidx + 1); }
                else {
                    const float gl = GLw[0];
                    f32x4 vt[4];
#pragma unroll
                    for (int mt = 0; mt < 4; ++mt)
#pragma unroll
                        for (int jj = 0; jj < 4; ++jj) vt[mt][jj] = bf2f(VL[(16 * mt + 4 * q + jj) * 40 + vl]);
                    f32x4 acc[4] = {{0.f, 0.f, 0.f, 0.f}, {0.f, 0.f, 0.f, 0.f}, {0.f, 0.f, 0.f, 0.f}, {0.f, 0.f, 0.f, 0.f}};
                    bf16x8 sfr[4];
#pragma unroll
                    for (int ks = 0; ks < 4; ++ks) sfr[ks] = *(const LAS bf16x8*)(ST + vl * 136 + 32 * ks + 8 * q);
#pragma unroll
                    for (int mt = 0; mt < 4; ++mt)
#pragma unroll
                        for (int ks = 0; ks < 4; ++ks) {
                            const bf16x8 a = *(const LAS bf16x8*)(Kg + (16 * mt + n) * 136 + 32 * ks + 8 * q);
                            acc[mt] = __builtin_amdgcn_mfma_f32_16x16x32_bf16(a, sfr[ks], acc[mt], 0, 0, 0);
                        }
#pragma unroll
                    for (int mt = 0; mt < 4; ++mt) { const f32x4 d = vt[mt] - acc[mt]; u32x2 w; w.x = pk2(d[0], d[1]); w.y = pk2(d[2], d[3]); *(LAS u32x2*)(XT + vl * 72 + 16 * mt + 4 * q) = w; }
                    f32x4 vn[4] = {{0.f, 0.f, 0.f, 0.f}, {0.f, 0.f, 0.f, 0.f}, {0.f, 0.f, 0.f, 0.f}, {0.f, 0.f, 0.f, 0.f}};
                    bf16x8 xf[2];
#pragma unroll
                    for (int ks = 0; ks < 2; ++ks) xf[ks] = *(const LAS bf16x8*)(XT + vl * 72 + 32 * ks + 8 * q);
#pragma unroll
                    for (int mt = 0; mt < 4; ++mt)
#pragma unroll
                        for (int ks = 0; ks < 2; ++ks) {
                            const bf16x8 a = *(const LAS bf16x8*)(Tp + (16 * mt + n) * 72 + 32 * ks + 8 * q);
                            vn[mt] = __builtin_amdgcn_mfma_f32_16x16x32_bf16(a, xf[ks], vn[mt], 0, 0, 0);
                        }
#pragma unroll
                    for (int mt = 0; mt < 4; ++mt) { u32x2 w; w.x = pk2(vn[mt][0], vn[mt][1]); w.y = pk2(vn[mt][2], vn[mt][3]); *(LAS u32x2*)(XT + vl * 72 + 16 * mt + 4 * q) = w; }
#pragma unroll
                    for (int ks = 0; ks < 2; ++ks) xf[ks] = *(const LAS bf16x8*)(XT + vl * 72 + 32 * ks + 8 * q);
#pragma unroll
                    for (int kt = 0; kt < 8; ++kt) {
                        Sacc[kt] = Sacc[kt] * gl;
#pragma unroll
                        for (int ks = 0; ks < 2; ++ks) {
                            const bf16x8 a = *(const LAS bf16x8*)(KdT + (16 * kt + n) * 72 + 32 * ks + 8 * q);
                            Sacc[kt] = __builtin_amdgcn_mfma_f32_16x16x32_bf16(a, xf[ks], Sacc[kt], 0, 0, 0);
                        }
                        u32x2 w; w.x = pk2(Sacc[kt][0], Sacc[kt][1]); w.y = pk2(Sacc[kt][2], Sacc[kt][3]);
                        *(LAS u32x2*)(ST + vl * 136 + 16 * kt + 4 * q) = w;
                    }
                    f32x4 oo[4] = {{0.f, 0.f, 0.f, 0.f}, {0.f, 0.f, 0.f, 0.f}, {0.f, 0.f, 0.f, 0.f}, {0.f, 0.f, 0.f, 0.f}};
#pragma unroll
                    for (int mt = 0; mt < 4; ++mt) {
#pragma unroll
                        for (int ks = 0; ks < 4; ++ks) {
                            const bf16x8 a = *(const LAS bf16x8*)(Qd + (16 * mt + n) * 136 + 32 * ks + 8 * q);
                            oo[mt] = __builtin_amdgcn_mfma_f32_16x16x32_bf16(a, sfr[ks], oo[mt], 0, 0, 0);
                        }
#pragma unroll
                        for (int ks = 0; ks < 2; ++ks) {
                            const bf16x8 a = *(const LAS bf16x8*)(Qk + (16 * mt + n) * 72 + 32 * ks + 8 * q);
                            oo[mt] = __builtin_amdgcn_mfma_f32_16x16x32_bf16(a, xf[ks], oo[mt], 0, 0, 0);
                        }
                    }
#pragma unroll
                    for (int mt = 0; mt < 4; ++mt)
#pragma unroll
                        for (int jj = 0; jj < 4; ++jj) OB[(size_t)(r0 + 16 * mt + 4 * q + jj) * D + h * 128 + v] = (bf16)f2bf(oo[mt][jj]);
                }
            }
            if (cw) {
                float* dsto = P->out + (prm ? O_DELTA_P : O_DELTA_S) + ((size_t)b * 8 + h) * 16384;
#pragma unroll
                for (int kt = 0; kt < 8; ++kt)
#pragma unroll
                    for (int jj = 0; jj < 4; ++jj) dsto[(size_t)(16 * kt + 4 * q + jj) * 128 + v] = Sacc[kt][jj];
            }
        }
#undef SCAN_PREFETCH
        __builtin_amdgcn_s_setprio(0);
        if (bid >= 128) {
            LBAR();
            SchedScanG S; S.XNp = XN; S.Bz = WIN + (size_t)6144 * D; S.Bgb = WIN + (size_t)8192 * D; S.Bga = WIN + (size_t)7168 * D; S.c = bid - 128;
            pg8::gemm_phase(lds, D, D, S, E);
        }
    }
    xcd_barrier(xbar);

    {
        PHASE_BEGIN
        for (int r = gw; r < MTOK; r += NGW) {
#pragma unroll
            for (int hf = 0; hf < 2; ++hf) {
                const size_t o = (size_t)r * D + hf * 512 + lane * 8;
                const u32x4 ov = *(const u32x4*)(OB + o), zv = *(const u32x4*)(ZB + o);
                float x[8] = {bflo(ov.x), bfhi(ov.x), bflo(ov.y), bfhi(ov.y), bflo(ov.z), bfhi(ov.z), bflo(ov.w), bfhi(ov.w)};
                const float z[8] = {bflo(zv.x), bfhi(zv.x), bflo(zv.y), bfhi(zv.y), bflo(zv.z), bfhi(zv.z), bflo(zv.w), bfhi(zv.w)};
                float s = 0.f;
#pragma unroll
                for (int e = 0; e < 8; ++e) s += x[e] * x[e];
                s = row16_sum(s);
                const float rs = __builtin_amdgcn_rsqf(s * (1.f / 128.f) + EPS);
                const float* gp = P->out_norm_g + (lane & 15) * 8;
                const f32x4 g0 = *(const f32x4*)gp, g1 = *(const f32x4*)(gp + 4);
                u32x4 w;
                w.x = pk2(x[0] * rs * g0[0] * z[0], x[1] * rs * g0[1] * z[1]); w.y = pk2(x[2] * rs * g0[2] * z[2], x[3] * rs * g0[3] * z[3]);
                w.z = pk2(x[4] * rs * g1[0] * z[4], x[5] * rs * g1[1] * z[5]); w.w = pk2(x[6] * rs * g1[2] * z[6], x[7] * rs * g1[3] * z[7]);
                *(u32x4*)(OB + o) = w;
            }
        }
    }
    xcd_barrier(xbar);

    {
        PHASE_BEGIN
        SchedPair64 SP; SP.A0 = OB; SP.B0 = WB; SP.k0 = K_YB; SP.A1 = XN; SP.B1 = WIN + (size_t)8192 * D; SP.k1 = K_GB; SP.G = G; SP.c = bid;
        pg8::gemm_phase(lds, D, D, SP, E);
        SchedSlice T; T.A = OB; T.B = WB; T.kind = K_YBS; T.G = G; T.c = bid; T.ld = D; T.ks = 128;
        pg8::gemm_phase(lds, 128, D, T, E);
    }
    xcd_barrier(xbar);
    {
        PHASE_BEGIN
        for (int i = bid * 512 + tid; i < 2048 * D / 8; i += G * 512) {
            bf16* ym = R3 + (size_t)MPROMPT * D + (size_t)i * 8;
            u32x4 pw[8];
#pragma unroll
            for (int sl = 0; sl < 8; ++sl) pw[sl] = *(const u32x4*)(R1 + (size_t)sl * 2048 * D + (size_t)i * 8);
            const u32x4 y = *(const u32x4*)ym;
            float a[8] = {bflo(y.x), bfhi(y.x), bflo(y.y), bfhi(y.y), bflo(y.z), bfhi(y.z), bflo(y.w), bfhi(y.w)};
#pragma unroll
            for (int sl = 0; sl < 8; ++sl) { a[0] += bflo(pw[sl].x); a[1] += bfhi(pw[sl].x); a[2] += bflo(pw[sl].y); a[3] += bfhi(pw[sl].y); a[4] += bflo(pw[sl].z); a[5] += bfhi(pw[sl].z); a[6] += bflo(pw[sl].w); a[7] += bfhi(pw[sl].w); }
            u32x4 w; w.x = pk2(a[0], a[1]); w.y = pk2(a[2], a[3]); w.z = pk2(a[4], a[5]); w.w = pk2(a[6], a[7]);
            *(u32x4*)ym = w;
        }
    }
    xcd_barrier(xbar);

    {
        PHASE_BEGIN
        SchedFull64 S; S.A = R3; S.B = WO; S.kind = K_O; S.G = G; S.c = bid; S.ld = D;
        pg8::gemm_phase(lds, D, D, S, E);
        SchedSlice T; T.A = R3; T.B = WO; T.kind = K_OS; T.G = G; T.c = bid; T.ld = D; T.ks = 128;
        pg8::gemm_phase(lds, 128, D, T, E);
    }
    xcd_barrier(xbar);

    {
        PHASE_BEGIN
        norm_phase<1>(P, ws, gw, NGW, lane);
        LAS float* scr = (LAS float*)(lds + wave * 8448);
        for (int base = gw; base < 4096; base += 2 * NGW) {
            TrItem t0 = tr_decode1(P, ws, base), t1 = t0; f32x4 v0[8], v1[8];
            const bool h1 = base + NGW < 4096;
            transpose_load(t0, v0, lane);
            if (h1) { t1 = tr_decode1(P, ws, base + NGW); transpose_load(t1, v1, lane); }
            transpose_finish(t0, v0, scr, lane);
            if (h1) transpose_finish(t1, v1, scr, lane);
        }
    }
    xcd_barrier(xbar);

    {
        PHASE_BEGIN
        SchedFlat S; S.A0 = S.A1 = S.A2 = XN; S.B0 = S.B1 = S.B2 = WFF1; S.n0 = 16; S.n1 = 0; S.n2 = 0; S.k0 = S.k1 = S.k2 = K_FF1; S.nN = 16; S.G = G; S.c = bid; S.K = D;
        pg8::gemm_phase(lds, D, D, S, E);
    }
    xcd_barrier(xbar);

    {
        PHASE_BEGIN
        SchedFull64 S; S.A = R1; S.B = WFF2; S.kind = K_FF2; S.G = G; S.c = bid; S.ld = FF;
        pg8::gemm_phase(lds, FF, FF, S, E);
        SchedSlice T; T.A = R1; T.B = WFF2; T.kind = K_FF2S; T.G = G; T.c = bid; T.ld = FF; T.ks = 512;
        pg8::gemm_phase(lds, 512, FF, T, E);
    }
    xcd_barrier(xbar);

    { PHASE_BEGIN
      norm_phase<2>(P, ws, gw, NGW, lane); }
}

extern "C" void kernel_launch(void* const* d_in, const int* in_sizes, int n_in, void* d_out, int out_size, void* d_ws, size_t ws_size, hipStream_t stream) {
    static int grid_blocks = 0;
    if (grid_blocks == 0) {
        if (n_in != 25 || ws_size < WS_END) { fprintf(stderr, "kernel_launch: unexpected n_in %d / ws_size %zu\n", n_in, ws_size); grid_blocks = -1; return; }
        int dev = 0, cus = 0, per_cu = 0;
        hipGetDevice(&dev);
        hipDeviceGetAttribute(&cus, hipDeviceAttributeMultiprocessorCount, dev);
        if (hipFuncSetAttribute((const void*)mega_fwd, hipFuncAttributeMaxDynamicSharedMemorySize, LDS_BYTES) != hipSuccess) { fprintf(stderr, "kernel_launch: hipFuncSetAttribute failed\n"); grid_blocks = -1; return; }
        hipOccupancyMaxActiveBlocksPerMultiprocessor(&per_cu, (const void*)mega_fwd, 512, LDS_BYTES);
        if (per_cu < 1) { fprintf(stderr, "kernel_launch: occupancy query gave %d\n", per_cu); per_cu = 1; }
        (void)hipGetLastError();
        grid_blocks = cus;
        if (cus != 256) { fprintf(stderr, "kernel_launch: the unit schedules are written for 256 CUs, found %d\n", cus); grid_blocks = -1; return; }
        fprintf(stderr, "kernel_launch: grid %d (per_cu %d), ws %zu\n", grid_blocks, per_cu, ws_size);
    }
    if (grid_blocks < 0) return;
    Params p{};
    const float** pp = (const float**)&p;
    for (int i = 0; i < 25; ++i) pp[i] = (const float*)d_in[i];
    p.out = (float*)d_out; p.ws = (unsigned char*)d_ws;
    if (hipMemsetAsync((char*)d_ws + WS_BAR, 0, BAR_BYTES, stream) != hipSuccess) { fprintf(stderr, "kernel_launch: memset of the barrier words failed\n"); return; }
    void* args[] = {&p};
    hipError_t e = hipLaunchCooperativeKernel((const void*)mega_fwd, dim3(grid_blocks), dim3(512), args, LDS_BYTES, stream);
    if (e != hipSuccess) fprintf(stderr, "cooperative launch failed: %s (grid %d)\n", hipGetErrorString(e), grid_blocks);
}
```

```cpp
#include <hip/hip_runtime.h>
#include <hip/hip_cooperative_groups.h>
#include <cstdio>
#include <cstdint>
namespace cg = cooperative_groups;

#define LAS __attribute__((address_space(3)))
typedef unsigned short bf16;
typedef short bf16x8 __attribute__((ext_vector_type(8)));
typedef float f32x4 __attribute__((ext_vector_type(4)));
typedef unsigned u32x4 __attribute__((ext_vector_type(4)));
typedef unsigned u32x2 __attribute__((ext_vector_type(2)));

constexpr int D = 1024, MTOK = 18432, MPROMPT = 16384, NB = 36, FF = 4096;
constexpr int NCHUNK = 288;
constexpr float EPS = 1e-6f;
constexpr size_t MiB = 1u << 20;
constexpr size_t WS_MOD = 0, WS_MODF = 1 * MiB, WS_G = 2 * MiB, WS_BETA = 3 * MiB, WS_HALO = 4 * MiB, WS_GC = 10 * MiB, WS_BAR = 11 * MiB, BAR_BYTES = 16384;
constexpr size_t WS_WIN = 12 * MiB, WS_WA = 31 * MiB, WS_WB = 33 * MiB, WS_WO = 35 * MiB;
constexpr size_t WS_XN = 38 * MiB, WS_R3 = 74 * MiB, WS_R1 = 110 * MiB, WS_R2 = 218 * MiB, WS_END = 254 * MiB;
constexpr size_t WS_WFF1 = WS_R3, WS_WFF2 = WS_R3 + 8 * MiB;
constexpr int LDS_BYTES = 147456;
constexpr size_t O_CONVA_P = 18874368, O_CONVQ_P = 18882560, O_DELTA_P = 18919424, O_CONVA_S = 19443712, O_CONVQ_S = 19509248, O_DELTA_S = 19804160;

struct Params {
    const float *x_prompt, *x_sample, *cache_conv_a, *cache_conv_qkv, *state_delta, *c_prompt, *c_sample,
        *ada_w, *ada_b, *norm1_g, *norm2_g, *w_in, *conv_a_w, *conv_qkv_w, *a_log, *dt_bias, *out_norm_g,
        *w_a_out, *w_b_out, *w_o, *w_ff1, *w_ff2, *final_ada_w, *final_ada_b, *final_norm_g;
    float* out; unsigned char* ws;
};
typedef const __attribute__((address_space(4))) Params* KP;
__device__ __forceinline__ KP kp_get() { KP k = (KP)__builtin_amdgcn_kernarg_segment_ptr(); asm volatile("" : "+s"(k)); return k; }

typedef float f32x2_t __attribute__((ext_vector_type(2)));
typedef __bf16 bf16x2_t __attribute__((ext_vector_type(2)));
__device__ __forceinline__ unsigned pk2(float lo, float hi) { f32x2_t v = {lo, hi}; bf16x2_t b = __builtin_convertvector(v, bf16x2_t); return __builtin_bit_cast(unsigned, b); }
__device__ __forceinline__ unsigned f2bf(float f) { return pk2(f, 0.f) & 0xffffu; }
__device__ __forceinline__ float bflo(unsigned w) { return __builtin_bit_cast(float, w << 16); }
__device__ __forceinline__ float bfhi(unsigned w) { return __builtin_bit_cast(float, w & 0xffff0000u); }
__device__ __forceinline__ float bf2f(bf16 v) { return __builtin_bit_cast(float, ((unsigned)v) << 16); }
__device__ __forceinline__ float sigmoidf_(float x) { return __builtin_amdgcn_rcpf(1.f + __expf(-x)); }
__device__ __forceinline__ float siluf_(float x) { return x * __builtin_amdgcn_rcpf(1.f + __expf(-x)); }
template <int CTRL> __device__ __forceinline__ float dpp_mov(float v) { return __builtin_bit_cast(float, __builtin_amdgcn_update_dpp(0, __builtin_bit_cast(int, v), CTRL, 0xF, 0xF, true)); }
__device__ __forceinline__ float row16_sum(float v) {
    v += dpp_mov<0xB1>(v);
    v += dpp_mov<0x4E>(v);
    v += dpp_mov<0x141>(v);
    v += dpp_mov<0x140>(v);
    return v;
}
__device__ __forceinline__ float wave_sum(float v) {
    v = row16_sum(v);
    const int vi = __builtin_bit_cast(int, v);
    const float r0 = __builtin_bit_cast(float, __builtin_amdgcn_readlane(vi, 0)), r1 = __builtin_bit_cast(float, __builtin_amdgcn_readlane(vi, 16));
    const float r2 = __builtin_bit_cast(float, __builtin_amdgcn_readlane(vi, 32)), r3 = __builtin_bit_cast(float, __builtin_amdgcn_readlane(vi, 48));
    return (r0 + r1) + (r2 + r3);
}
__device__ __forceinline__ int batch_of(int r) { return r < MPROMPT ? (r >> 12) : 4 + ((r - MPROMPT) >> 6); }
#define LDS_WAIT() asm volatile("s_waitcnt lgkmcnt(0)" ::: "memory")

#define XB_TMO      128
#define XB_XCNT(j)  (256  + 64 * (j))
#define XB_XSUB(j)  (1280 + 64 * (j))
#define XB_XGEN(j)  (2304 + 64 * (j))
#define XB_TOP      3328
#define XB_TOPGEN   3392
#define XCD_BAR_WORDS 3456
#define XB_SPIN_CAP (1u << 18)

__device__ __forceinline__ unsigned xb_ld(unsigned* p)              { return __hip_atomic_load(p, __ATOMIC_RELAXED, __HIP_MEMORY_SCOPE_AGENT); }
__device__ __forceinline__ unsigned xb_add(unsigned* p, unsigned v) { return __hip_atomic_fetch_add(p, v, __ATOMIC_RELAXED, __HIP_MEMORY_SCOPE_AGENT); }
__device__ __forceinline__ unsigned xb_xcc_id() { return (unsigned)__builtin_amdgcn_s_getreg((3 << 11) | 20) & 0xFu; }
#define XB_SPIN(cond, bar) do { unsigned _sp = 0; while (cond) { __builtin_amdgcn_s_sleep(1); \
    if ((++_sp & 255u) == 0u) { if (xb_ld(&(bar)[XB_TMO])) break; if (_sp > XB_SPIN_CAP) { atomicAdd(&(bar)[XB_TMO], 1u); break; } } } } while (0)

struct XcdBarrier {
    unsigned* bar; unsigned x;
    volatile LAS unsigned* st;
};

__device__ __forceinline__ XcdBarrier xcd_barrier_post(unsigned* bar, volatile LAS unsigned* st) {
    XcdBarrier b; b.bar = bar; b.x = xb_xcc_id(); b.st = st;
    if (threadIdx.x == 0) (void)xb_add(&bar[XB_XCNT(b.x)], 1u);
    return b;
}
__device__ __forceinline__ void xcd_barrier_complete(unsigned* bar, unsigned x, unsigned& nloc, unsigned& nx) {
    const unsigned G = gridDim.x * gridDim.y * gridDim.z;
    unsigned sum, cnt, mine, sp = 0u;
    for (;;) {
        sum = 0u; cnt = 0u; mine = 0u;
#pragma unroll
        for (unsigned j = 0; j < 16; ++j) { const unsigned c = xb_ld(&bar[XB_XCNT(j)]); sum += c; cnt += (c > 0u) ? 1u : 0u; mine = (j == x) ? c : mine; }
        if (sum == G) break;
        __builtin_amdgcn_s_sleep(1);
        if ((++sp & 255u) == 0u) { if (xb_ld(&bar[XB_TMO])) break; if (sp > XB_SPIN_CAP) { atomicAdd(&bar[XB_TMO], 1u); break; } }
    }
    nloc = mine > 0u ? mine : 1u; nx = cnt > 0u ? cnt : 1u;
}

__device__ __forceinline__ void xcd_barrier(const XcdBarrier& b) {
    asm volatile("s_waitcnt vmcnt(0)" ::: "memory");
    __syncthreads();
    if (threadIdx.x == 0) {
        unsigned* bar = b.bar;
        __builtin_amdgcn_s_waitcnt(0);
        unsigned nloc = b.st[0], nx = b.st[1];
        if (nloc == 0u) { xcd_barrier_complete(bar, b.x, nloc, nx); b.st[0] = nloc; b.st[1] = nx; }
        const unsigned old = xb_add(&bar[XB_XSUB(b.x)], 1u);
        const unsigned gen = old / nloc;
        if (old + 1u == (gen + 1u) * nloc) {
            __builtin_amdgcn_fence(__ATOMIC_RELEASE, "agent");
            asm volatile("s_waitcnt vmcnt(0)" ::: "memory");
            const unsigned og = xb_add(&bar[XB_TOP], 1u);
            const unsigned tg = og / nx;
            if (og + 1u == (tg + 1u) * nx) xb_add(&bar[XB_TOPGEN], 1u);
            else XB_SPIN(xb_ld(&bar[XB_TOPGEN]) == tg, bar);
            __builtin_amdgcn_fence(__ATOMIC_ACQUIRE, "agent");
            xb_add(&bar[XB_XGEN(b.x)], 1u);
            asm volatile("s_waitcnt vmcnt(0)" ::: "memory");
        } else {
            XB_SPIN(xb_ld(&bar[XB_XGEN(b.x)]) == gen, bar);
            __builtin_amdgcn_fence(__ATOMIC_ACQUIRE, "agent");
            asm volatile("s_waitcnt vmcnt(0)" ::: "memory");
        }
    }
    __syncthreads();
}


namespace pg8 {
constexpr int BM = 256, BK = 64, HALF = 128, HTB = HALF * BK * 2, STAGE_BYTES = 8 * HTB, NXCD = 8, WGM = 8;
__host__ __device__ __forceinline__ int lds_byte(int r, int c) { const int st = (r >> 4) * 2 + (c >> 5), rr = r & 15, cc = c & 31, ob = rr * 64 + cc * 2; return st * 1024 + (ob ^ (((ob >> 9) & 1) << 5)); }
__host__ __device__ __forceinline__ void stage_rc(int b, int& R, int& C) { const int st = b / 1024, sb = b % 1024, swz = sb ^ (((sb >> 9) & 1) << 5); R = (st >> 1) * 16 + swz / 64; C = (st & 1) * 32 + (swz % 64) / 2; }
__host__ __device__ __forceinline__ int perm32(int rho) { const int n = rho >> 4, i = rho & 15; return 8 * (i >> 2) + 4 * n + (i & 3); }

struct Unit { int pm, pn, kind, aux; const char* A; const char* Bt; };

__device__ __forceinline__ void decode_tile(int L, int nM, int nN, int& pm, int& pn) {
    const int nwg = nM * nN; int wgid = L;
    { const int q = nwg / NXCD, r = nwg % NXCD, xcd = wgid % NXCD, off = wgid / NXCD; wgid = (xcd < r ? xcd * (q + 1) : r * (q + 1) + (xcd - r) * q) + off; }
    const int nig = WGM * nN, gid = wgid / nig, fm = gid * WGM, gsz = (nM - fm) < WGM ? (nM - fm) : WGM;
    pm = fm + ((wgid % nig) % gsz); pn = (wgid % nig) / gsz;
}

template <class Sched, class Epi>
__device__ __forceinline__ void gemm_phase(LAS unsigned char* lds, const int K, const int ldk, const Sched& S, const Epi& E) {
    int tid = threadIdx.x; asm volatile("" : "+v"(tid));
    const int wid = __builtin_amdgcn_readfirstlane(tid >> 6), lane = tid & 63, wr = wid >> 2, wc = wid & 3, fr = lane & 15, fq = lane >> 4;
    const int nt = K / BK;
    unsigned voffA[2], voffB[2];
#pragma unroll
    for (int i = 0; i < 2; ++i) { int R, C; stage_rc(tid * 16 + i * 8192, R, C); const int Rb = (R & ~31) + perm32(R & 31);
        voffA[i] = (unsigned)(R * ldk + C) * 2u; voffB[i] = (unsigned)(Rb * ldk + C) * 2u; }
    const size_t kstep = (size_t)(BK * 2);
    const size_t hstep = (size_t)HALF * ldk * 2;
    const unsigned ldsw = (unsigned)wid * 1024u;
    const int aoff = lds_byte(wr * 64 + fr, fq * 8), boff = lds_byte(wc * 32 + fr, fq * 8);
#define PG8_SA(b, h) (((b) * 2 + (h)) * HTB)
#define PG8_SB(b, h) ((4 + (b) * 2 + (h)) * HTB)
#define PG8_STAGE(bufoff, gbase, voff) do { _Pragma("unroll") for (int _i = 0; _i < 2; ++_i) \
        __builtin_amdgcn_global_load_lds((const unsigned*)((const char*)(gbase) + (voff)[_i]), (LAS unsigned*)(lds + (bufoff) + ldsw + _i * 8192), 16, 0, 0); } while (0)
#define PG8_LDA(dst, b, h) do { _Pragma("unroll") for (int m = 0; m < 4; ++m) _Pragma("unroll") for (int k = 0; k < 2; ++k) dst[m][k] = *(const LAS bf16x8*)(lds + PG8_SA(b, h) + aoff + m * 2048 + k * 1024); } while (0)
#define PG8_LDB(dst, b, h) do { _Pragma("unroll") for (int n = 0; n < 2; ++n) _Pragma("unroll") for (int k = 0; k < 2; ++k) dst[n][k] = *(const LAS bf16x8*)(lds + PG8_SB(b, h) + boff + n * 2048 + k * 1024); } while (0)
#define PG8_MMA(ai, bj, At, Bt) do { __builtin_amdgcn_s_setprio(1); _Pragma("unroll") for (int m = 0; m < 4; ++m) _Pragma("unroll") for (int n = 0; n < 2; ++n) _Pragma("unroll") for (int k = 0; k < 2; ++k) \
        acc[ai][bj][m][n] = __builtin_amdgcn_mfma_f32_16x16x32_bf16(Bt[n][k], At[m][k], acc[ai][bj][m][n], 0, 0, 0); __builtin_amdgcn_s_setprio(0); } while (0)
#define PG8_WAIT_V(n) asm volatile("s_waitcnt vmcnt(" #n ")" ::: "memory")
#define PG8_WAIT_L(n) asm volatile("s_waitcnt lgkmcnt(" #n ")" ::: "memory")
#define PG8_BAR __builtin_amdgcn_s_barrier()
#define PG8_SCHED __builtin_amdgcn_sched_barrier(0)
    Unit cur, nxt; int ui = 0;
    if (!S.next(0, cur)) return;
    f32x4 acc[2][2][4][2];
#pragma unroll
    for (int a = 0; a < 2; ++a)
#pragma unroll
        for (int b = 0; b < 2; ++b)
#pragma unroll
            for (int m = 0; m < 4; ++m)
#pragma unroll
                for (int n = 0; n < 2; ++n) acc[a][b][m][n] = (f32x4){0.f, 0.f, 0.f, 0.f};
    bf16x8 At[4][2], B0[2][2], B1[2][2];
    const char* cA = cur.A; const char* cB = cur.Bt;
    PG8_STAGE(PG8_SB(0, 0), cB, voffB); PG8_STAGE(PG8_SB(0, 1), cB + hstep, voffB); PG8_STAGE(PG8_SA(0, 0), cA, voffA); PG8_STAGE(PG8_SA(0, 1), cA + hstep, voffA);
    if (wr == 1) PG8_BAR;
    PG8_WAIT_V(2); PG8_BAR;
    PG8_STAGE(PG8_SB(1, 0), cB + kstep, voffB); PG8_STAGE(PG8_SA(1, 0), cA + kstep, voffA); PG8_STAGE(PG8_SB(1, 1), cB + hstep + kstep, voffB);
    PG8_WAIT_V(6); PG8_BAR;
    for (;;) {
        const bool has_next = S.next(ui + 1, nxt);
        const char* nA = has_next ? nxt.A : cA; const char* nB = has_next ? nxt.Bt : cB;
        for (int t = 0; t < nt; t += 2) {
            const bool last = (t == nt - 2);
            const char* a1 = cA + (size_t)(t + 1) * kstep;
            const char* a2 = last ? nA : cA + (size_t)(t + 2) * kstep; const char* b2 = last ? nB : cB + (size_t)(t + 2) * kstep;
            const char* a3 = a2 + kstep; const char* b3 = b2 + kstep;
            PG8_LDB(B0, 0, 0); PG8_LDB(B1, 0, 1); PG8_SCHED; PG8_LDA(At, 0, 0); PG8_STAGE(PG8_SA(1, 1), a1 + hstep, voffA);
            PG8_WAIT_V(8); PG8_WAIT_L(0); PG8_BAR; PG8_MMA(0, 0, At, B0); PG8_MMA(0, 1, At, B1); PG8_BAR; PG8_SCHED;
            PG8_LDA(At, 0, 1); PG8_STAGE(PG8_SB(0, 0), b2, voffB); PG8_STAGE(PG8_SB(0, 1), b2 + hstep, voffB); PG8_STAGE(PG8_SA(0, 0), a2, voffA);
            PG8_WAIT_V(8); PG8_WAIT_L(0); PG8_BAR; PG8_MMA(1, 0, At, B0); PG8_MMA(1, 1, At, B1); PG8_BAR; PG8_SCHED;
            PG8_LDB(B0, 1, 0); PG8_LDB(B1, 1, 1); PG8_SCHED; PG8_LDA(At, 1, 0); PG8_STAGE(PG8_SA(0, 1), a2 + hstep, voffA);
            PG8_WAIT_V(8); PG8_WAIT_L(0); PG8_BAR; PG8_MMA(0, 0, At, B0); PG8_MMA(0, 1, At, B1); PG8_BAR; PG8_SCHED;
            PG8_LDA(At, 1, 1); PG8_STAGE(PG8_SB(1, 0), b3, voffB); PG8_STAGE(PG8_SB(1, 1), b3 + hstep, voffB); PG8_STAGE(PG8_SA(1, 0), a3, voffA);
            PG8_WAIT_V(8); PG8_WAIT_L(0); PG8_BAR; PG8_MMA(1, 0, At, B0); PG8_MMA(1, 1, At, B1); PG8_BAR; PG8_SCHED;
        }
        if (wr == 0) PG8_BAR;
        E(acc, cur, wr, wc, fr, fq);
        if (!has_next) break;
#pragma unroll
        for (int a = 0; a < 2; ++a)
#pragma unroll
            for (int b = 0; b < 2; ++b)
#pragma unroll
                for (int m = 0; m < 4; ++m)
#pragma unroll
                    for (int n = 0; n < 2; ++n) acc[a][b][m][n] = (f32x4){0.f, 0.f, 0.f, 0.f};
        cur = nxt; cA = nA; cB = nB; ++ui;
        if (wr == 1) PG8_BAR;
    }
    PG8_WAIT_V(0);
    PG8_BAR;
#undef PG8_SA
#undef PG8_SB
#undef PG8_STAGE
#undef PG8_LDA
#undef PG8_LDB
#undef PG8_MMA
#undef PG8_WAIT_V
#undef PG8_WAIT_L
#undef PG8_BAR
#undef PG8_SCHED
}
}

enum { K_PA = 0, K_PQ, K_AB, K_Z, K_YA, K_GA, K_YB, K_GB, K_O, K_FF1, K_FF2, K_OS, K_FF2S, K_SGT, K_YBS };

struct Epi {
    __device__ __forceinline__ void operator()(const f32x4 (&acc)[2][2][4][2], const pg8::Unit& u, int wr, int wc, int fr, int fq) const {
        const KP P = kp_get();
        unsigned char* ws = P->ws;
        const int kind = u.kind;
        const int rbase = u.pm * 256 + wr * 64 + fr, cbase = u.pn * 256 + wc * 32 + 8 * fq;
#define EPI_PACK(w, v0, v1) do { w.x = pk2(v0[0], v0[1]); w.y = pk2(v0[2], v0[3]); w.z = pk2(v1[0], v1[1]); w.w = pk2(v1[2], v1[3]); } while (0)
        if (kind == K_PA && u.pn >= 4) {
            bf16* base = (bf16*)(ws + WS_R1) + 1024 + 128 * (u.pn - 4) + wc * 32 + 8 * fq;
#pragma unroll
            for (int ai = 0; ai < 2; ++ai)
#pragma unroll
                for (int m = 0; m < 4; ++m) {
                    const f32x4 v0 = acc[ai][0][m][0] * acc[ai][1][m][0], v1 = acc[ai][0][m][1] * acc[ai][1][m][1];
                    u32x4 w; EPI_PACK(w, v0, v1);
                    *(u32x4*)(base + (size_t)(rbase + ai * 128 + m * 16) * 3072) = w;
                }
        } else if (kind == K_PA || kind == K_PQ || kind == K_FF1 || kind == K_Z || kind == K_YA || kind == K_YB) {
            bf16* base; int ld;
            if (kind == K_PA || kind == K_PQ) { base = (bf16*)(ws + WS_R1); ld = 3072; }
            else if (kind == K_FF1) { base = (bf16*)(ws + WS_R1); ld = FF; }
            else if (kind == K_YA) { base = (bf16*)(ws + WS_R3); ld = D; }
            else { base = (bf16*)P->out; ld = D; }
#pragma unroll
            for (int ai = 0; ai < 2; ++ai)
#pragma unroll
                for (int m = 0; m < 4; ++m) {
                    const int r = rbase + ai * 128 + m * 16;
#pragma unroll
                    for (int bj = 0; bj < 2; ++bj) {
                        const int c0 = cbase + bj * 128;
                        f32x4 v0 = acc[ai][bj][m][0], v1 = acc[ai][bj][m][1];
                        if (kind == K_FF1) {
#pragma unroll
                            for (int e = 0; e < 4; ++e) { float x = fmaxf(v0[e], 0.f), y = fmaxf(v1[e], 0.f); v0[e] = x * x; v1[e] = y * y; }
                        } else if (kind == K_Z) {
#pragma unroll
                            for (int e = 0; e < 4; ++e) { v0[e] = siluf_(v0[e]); v1[e] = siluf_(v1[e]); }
                        }
                        u32x4 w; EPI_PACK(w, v0, v1);
                        *(u32x4*)(base + (size_t)r * ld + c0) = w;
                        if (kind == K_PQ && (r & 63) >= 61) *(u32x4*)((bf16*)(ws + WS_HALO) + ((size_t)(r >> 6) * 3 + ((r & 63) - 61)) * 3072 + c0) = w;
                    }
                }
        } else if (kind == K_AB) {
            if (wc == 0 && fq < 2) {
                float ea[8], db[8];
#pragma unroll
                for (int e = 0; e < 8; ++e) { ea[e] = -__expf(P->a_log[e]); db[e] = P->dt_bias[e]; }
#pragma unroll
                for (int ai = 0; ai < 2; ++ai)
#pragma unroll
                    for (int m = 0; m < 4; ++m) {
                        const int r = rbase + ai * 128 + m * 16;
                        const f32x4 v0 = acc[ai][0][m][0], v1 = acc[ai][0][m][1];
                        f32x4 o0, o1;
                        if (fq == 0) {
#pragma unroll
                            for (int e = 0; e < 4; ++e) {
                                const float a0 = v0[e] + db[e], a1 = v1[e] + db[4 + e];
                                const float s0 = a0 > 20.f ? a0 : __logf(1.f + __expf(a0)), s1 = a1 > 20.f ? a1 : __logf(1.f + __expf(a1));
                                o0[e] = ea[e] * s0; o1[e] = ea[4 + e] * s1;
                            }
                            float* g = (float*)(ws + WS_G) + (size_t)r * 8; *(f32x4*)g = o0; *(f32x4*)(g + 4) = o1;
                        } else {
#pragma unroll
                            for (int e = 0; e < 4; ++e) { o0[e] = sigmoidf_(v0[e]); o1[e] = sigmoidf_(v1[e]); }
                            float* g = (float*)(ws + WS_BETA) + (size_t)r * 8; *(f32x4*)g = o0; *(f32x4*)(g + 4) = o1;
                        }
                    }
            }
        } else if (kind == K_GA || kind == K_GB) {
            bf16* ym = (bf16*)(ws + WS_R3); const bf16* yb = (const bf16*)P->out;
#pragma unroll
            for (int am = 0; am < 4; ++am) {
                const int ai = am >> 1, mh = (am & 1) * 2;
                u32x4 a[2][2], b[2][2];
#pragma unroll
                for (int m = 0; m < 2; ++m)
#pragma unroll
                    for (int bj = 0; bj < 2; ++bj) {
                        const size_t o = (size_t)(rbase + ai * 128 + (mh + m) * 16) * D + cbase + bj * 128;
                        a[m][bj] = *(const u32x4*)(ym + o);
                        if (kind == K_GB) b[m][bj] = *(const u32x4*)(yb + o); else b[m][bj] = (u32x4){0u, 0u, 0u, 0u};
                    }
#pragma unroll
                for (int m = 0; m < 2; ++m)
#pragma unroll
                    for (int bj = 0; bj < 2; ++bj) {
                        const size_t o = (size_t)(rbase + ai * 128 + (mh + m) * 16) * D + cbase + bj * 128;
                        const f32x4 v0 = acc[ai][bj][mh + m][0], v1 = acc[ai][bj][mh + m][1];
                        const u32x4 ya = a[m][bj], y2 = b[m][bj]; u32x4 w;
                        if (kind == K_GA) {
                            w.x = pk2(sigmoidf_(v0[0]) * bflo(ya.x), sigmoidf_(v0[1]) * bfhi(ya.x)); w.y = pk2(sigmoidf_(v0[2]) * bflo(ya.y), sigmoidf_(v0[3]) * bfhi(ya.y));
                            w.z = pk2(sigmoidf_(v1[0]) * bflo(ya.z), sigmoidf_(v1[1]) * bfhi(ya.z)); w.w = pk2(sigmoidf_(v1[2]) * bflo(ya.w), sigmoidf_(v1[3]) * bfhi(ya.w));
                        } else {
                            w.x = pk2(bflo(ya.x) + sigmoidf_(v0[0]) * bflo(y2.x), bfhi(ya.x) + sigmoidf_(v0[1]) * bfhi(y2.x));
                            w.y = pk2(bflo(ya.y) + sigmoidf_(v0[2]) * bflo(y2.y), bfhi(ya.y) + sigmoidf_(v0[3]) * bfhi(y2.y));
                            w.z = pk2(bflo(ya.z) + sigmoidf_(v1[0]) * bflo(y2.z), bfhi(ya.z) + sigmoidf_(v1[1]) * bfhi(y2.z));
                            w.w = pk2(bflo(ya.w) + sigmoidf_(v1[2]) * bflo(y2.w), bfhi(ya.w) + sigmoidf_(v1[3]) * bfhi(y2.w));
                        }
                        *(u32x4*)(ym + o) = w;
                    }
            }
        } else if (kind == K_SGT) {
            bf16* sg = (bf16*)(ws + WS_HALO) - (size_t)MPROMPT * D;
#pragma unroll
            for (int ai = 0; ai < 2; ++ai)
#pragma unroll
                for (int m = 0; m < 4; ++m)
#pragma unroll
                    for (int bj = 0; bj < 2; ++bj) {
                        f32x4 v0 = acc[ai][bj][m][0], v1 = acc[ai][bj][m][1];
#pragma unroll
                        for (int e = 0; e < 4; ++e) { v0[e] = sigmoidf_(v0[e]); v1[e] = sigmoidf_(v1[e]); }
                        u32x4 w; EPI_PACK(w, v0, v1);
                        *(u32x4*)(sg + (size_t)(rbase + ai * 128 + m * 16) * D + cbase + bj * 128) = w;
                    }
        } else if (kind == K_YBS) {
            const bf16* sg = (const bf16*)(ws + WS_HALO) - (size_t)MPROMPT * D;
            bf16* part = (bf16*)(ws + WS_R1) + ((size_t)u.aux * 2048 - MPROMPT) * D;
#pragma unroll
            for (int ai = 0; ai < 2; ++ai) {
                u32x4 g[4][2];
#pragma unroll
                for (int m = 0; m < 4; ++m)
#pragma unroll
                    for (int bj = 0; bj < 2; ++bj) g[m][bj] = *(const u32x4*)(sg + (size_t)(rbase + ai * 128 + m * 16) * D + cbase + bj * 128);
#pragma unroll
                for (int m = 0; m < 4; ++m)
#pragma unroll
                    for (int bj = 0; bj < 2; ++bj) {
                        const f32x4 a0 = acc[ai][bj][m][0], a1 = acc[ai][bj][m][1]; const u32x4 gg = g[m][bj];
                        u32x4 w; w.x = pk2(bflo(gg.x) * a0[0], bfhi(gg.x) * a0[1]); w.y = pk2(bflo(gg.y) * a0[2], bfhi(gg.y) * a0[3]);
                        w.z = pk2(bflo(gg.z) * a1[0], bfhi(gg.z) * a1[1]); w.w = pk2(bflo(gg.w) * a1[2], bfhi(gg.w) * a1[3]);
                        *(u32x4*)(part + (size_t)(rbase + ai * 128 + m * 16) * D + cbase + bj * 128) = w;
                    }
            }
        } else if (kind == K_OS || kind == K_FF2S) {
            const float* modp = (const float*)(ws + WS_MOD);
            bf16* part = (bf16*)(ws + (kind == K_OS ? WS_R1 : WS_XN)) + ((size_t)u.aux * 2048 - MPROMPT) * D;
#pragma unroll
            for (int ai = 0; ai < 2; ++ai) {
                const int r0 = rbase + ai * 128;
                const float* gt = modp + (size_t)batch_of(r0) * 6144 + (kind == K_OS ? 2048 : 5120) + cbase;
#pragma unroll
                for (int bj = 0; bj < 2; ++bj) {
                    const f32x4 g0 = *(const f32x4*)(gt + bj * 128), g1 = *(const f32x4*)(gt + bj * 128 + 4);
#pragma unroll
                    for (int m = 0; m < 4; ++m) {
                        const f32x4 v0 = g0 * acc[ai][bj][m][0], v1 = g1 * acc[ai][bj][m][1];
                        u32x4 w; EPI_PACK(w, v0, v1);
                        *(u32x4*)(part + (size_t)(r0 + m * 16) * D + cbase + bj * 128) = w;
                    }
                }
            }
        } else {
            const float* modp = (const float*)(ws + WS_MOD);
#pragma unroll
            for (int am = 0; am < 4; ++am) {
                const int ai = am >> 1, mh = (am & 1) * 2;
                const int r0 = rbase + ai * 128 + mh * 16;
                const float* gt = modp + (size_t)batch_of(r0) * 6144 + (kind == K_O ? 2048 : 5120) + cbase;
                f32x4 g[2][2], x[2][2][2];
#pragma unroll
                for (int bj = 0; bj < 2; ++bj) { g[bj][0] = *(const f32x4*)(gt + bj * 128); g[bj][1] = *(const f32x4*)(gt + bj * 128 + 4); }
#pragma unroll
                for (int m = 0; m < 2; ++m) {
                    const int r = r0 + m * 16;
                    const float* xr = (kind == K_O) ? ((r < MPROMPT ? P->x_prompt + (size_t)r * D : P->x_sample + (size_t)(r - MPROMPT) * D) + cbase) : (P->out + (size_t)r * D + cbase);
#pragma unroll
                    for (int bj = 0; bj < 2; ++bj) { x[m][bj][0] = *(const f32x4*)(xr + bj * 128); x[m][bj][1] = *(const f32x4*)(xr + bj * 128 + 4); }
                }
#pragma unroll
                for (int m = 0; m < 2; ++m) {
                    float* dst = P->out + (size_t)(r0 + m * 16) * D + cbase;
#pragma unroll
                    for (int bj = 0; bj < 2; ++bj) {
                        *(f32x4*)(dst + bj * 128) = x[m][bj][0] + g[bj][0] * acc[ai][bj][mh + m][0];
                        *(f32x4*)(dst + bj * 128 + 4) = x[m][bj][1] + g[bj][1] * acc[ai][bj][mh + m][1];
                    }
                }
            }
        }
#undef EPI_PACK
    }
};

struct SchedFlat {
    const bf16 *A0, *A1, *A2; const bf16 *B0, *B1, *B2; int n0, n1, n2, k0, k1, k2; int nN, G, c, K;
    __device__ __forceinline__ bool next(int i, pg8::Unit& u) const {
        const long L = (long)i * G + c; if (L >= (long)72 * nN) return false;
        int pm, pg; pg8::decode_tile((int)L, 72, nN, pm, pg);
        const bf16* A; const bf16* B; int kind, pn;
        if (pg < n0) { A = A0; B = B0; kind = k0; pn = pg; }
        else if (pg < n0 + n1) { A = A1; B = B1; kind = k1; pn = pg - n0; }
        else { A = A2; B = B2; kind = k2; pn = pg - n0 - n1; }
        u.pm = pm; u.pn = pn; u.kind = kind; u.aux = 0;
        u.A = (const char*)A + (size_t)pm * 256 * K * 2; u.Bt = (const char*)B + (size_t)pn * 256 * K * 2;
        return true;
    }
};
struct SchedPair {
    const bf16 *A0, *A1; const bf16 *B0, *B1; int k0, k1; int G, c, K;
    __device__ __forceinline__ bool next(int i, pg8::Unit& u) const {
        const int j = i >> 1, half = i & 1; const long L = (long)j * G + c; if (L >= 288) return false;
        int pm, pn; pg8::decode_tile((int)L, 72, 4, pm, pn);
        u.pm = pm; u.pn = pn; u.kind = half ? k1 : k0; u.aux = 0;
        u.A = (const char*)(half ? A1 : A0) + (size_t)pm * 256 * K * 2; u.Bt = (const char*)(half ? B1 : B0) + (size_t)pn * 256 * K * 2;
        return true;
    }
};

struct SchedP2 {
    const bf16 *XNp, *Bp, *Bz; int c;
    __device__ __forceinline__ bool next(int i, pg8::Unit& u) const {
        const int L = i * 256 + c; if (L >= 1024) return false;
        int pm, pn; const bf16* B;
        if (L < 864) { pg8::decode_tile(L, 72, 12, pm, pn); u.kind = K_PA; B = Bp; } else { pg8::decode_tile(L - 864, 72, 4, pm, pn); u.kind = K_Z; B = Bz; }
        u.pm = pm; u.pn = pn; u.aux = 0;
        u.A = (const char*)XNp + (size_t)pm * 256 * D * 2; u.Bt = (const char*)B + (size_t)pn * 256 * D * 2;
        return true;
    }
};
struct SchedP4 {
    const bf16 *XNp, *Bqkv, *Bab, *YAp, *Bya, *Bz; int c;
    __device__ __forceinline__ bool next(int i, pg8::Unit& u) const {
        const int L = i * 256 + c; if (L >= 1280) return false;
        u.aux = 0;
        if (L >= 1224) {
            int pm, pn; pg8::decode_tile(160 + (L - 1224), 72, 4, pm, pn);
            u.pm = pm; u.pn = pn; u.kind = K_Z;
            u.A = (const char*)XNp + (size_t)pm * 256 * D * 2; u.Bt = (const char*)Bz + (size_t)pn * 256 * D * 2;
        } else if (L < 936) {
            int pm, pg; pg8::decode_tile(L, 72, 13, pm, pg);
            u.pm = pm; u.A = (const char*)XNp + (size_t)pm * 256 * D * 2;
            if (pg < 12) { u.pn = pg; u.kind = K_PQ; u.Bt = (const char*)Bqkv + (size_t)pg * 256 * D * 2; } else { u.pn = 0; u.kind = K_AB; u.Bt = (const char*)Bab; }
        } else {
            int pm, pn; pg8::decode_tile(L - 936, 72, 4, pm, pn);
            u.pm = pm; u.pn = pn; u.kind = K_YA;
            u.A = (const char*)YAp + (size_t)pm * 256 * D * 2; u.Bt = (const char*)Bya + (size_t)pn * 256 * D * 2;
        }
        return true;
    }
};
struct SchedScanG {
    const bf16 *XNp, *Bz, *Bgb, *Bga; int c;
    __device__ __forceinline__ bool next(int i, pg8::Unit& u) const {
        const int L = i * 128 + c; if (L >= 392) return false;
        int pm, pn; const bf16* B;
        if (L < 72) { pg8::decode_tile(216 + L, 72, 4, pm, pn); u.kind = K_Z; B = Bz; }
        else if (L < 104) { const int t = L - 72; pm = 64 + (t >> 2); pn = t & 3; u.kind = K_SGT; B = Bgb; }
        else { pg8::decode_tile(L - 104, 72, 4, pm, pn); u.kind = K_GA; B = Bga; }
        u.pm = pm; u.pn = pn; u.aux = 0;
        u.A = (const char*)XNp + (size_t)pm * 256 * D * 2; u.Bt = (const char*)B + (size_t)pn * 256 * D * 2;
        return true;
    }
};
struct SchedPair64 {
    const bf16 *A0, *A1; const bf16 *B0, *B1; int k0, k1; int G, c;
    __device__ __forceinline__ bool next(int i, pg8::Unit& u) const {
        const int j = i >> 1, half = i & 1; const long L = (long)j * G + c; if (L >= 256) return false;
        int pm, pn; pg8::decode_tile((int)L, 64, 4, pm, pn);
        u.pm = pm; u.pn = pn; u.kind = half ? k1 : k0; u.aux = 0;
        u.A = (const char*)(half ? A1 : A0) + (size_t)pm * 256 * D * 2; u.Bt = (const char*)(half ? B1 : B0) + (size_t)pn * 256 * D * 2;
        return true;
    }
};
struct SchedFull64 {
    const bf16 *A, *B; int kind, G, c, ld;
    __device__ __forceinline__ bool next(int i, pg8::Unit& u) const {
        const long L = (long)i * G + c; if (L >= 256) return false;
        int pm, pn; pg8::decode_tile((int)L, 64, 4, pm, pn);
        u.pm = pm; u.pn = pn; u.kind = kind; u.aux = 0;
        u.A = (const char*)A + (size_t)pm * 256 * ld * 2; u.Bt = (const char*)B + (size_t)pn * 256 * ld * 2;
        return true;
    }
};
struct SchedSlice {
    const bf16 *A, *B; int kind, G, c, ld, ks;
    __device__ __forceinline__ bool next(int i, pg8::Unit& u) const {
        const long L = (long)i * G + c; if (L >= 256) return false;
        const int tile = (int)L >> 3, sl = (int)L & 7;
        u.pm = 64 + (tile >> 2); u.pn = tile & 3; u.kind = kind; u.aux = sl;
        u.A = (const char*)A + ((size_t)u.pm * 256 * ld + (size_t)sl * ks) * 2; u.Bt = (const char*)B + ((size_t)u.pn * 256 * ld + (size_t)sl * ks) * 2;
        return true;
    }
};

struct TrItem { const float* W; bf16* WT; int ldw, K, src0, dst0, kb, nb, dnb; };
__device__ __forceinline__ void transpose_load(const TrItem& t, f32x4 (&v)[8], int lane) {
    const int kk = lane >> 3, c4 = (lane & 7) * 4;
#pragma unroll
    for (int i = 0; i < 8; ++i) v[i] = *(const f32x4*)(t.W + (size_t)(64 * t.kb + 8 * i + kk) * t.ldw + t.src0 + 32 * t.nb + c4);
}
__device__ __forceinline__ void transpose_finish(const TrItem& t, const f32x4 (&v)[8], LAS float* scr, int lane) {
    const int kk = lane >> 3, c4 = (lane & 7) * 4;
#pragma unroll
    for (int i = 0; i < 8; ++i) { LAS float* d = scr + (8 * i + kk) * 33 + c4; d[0] = v[i].x; d[1] = v[i].y; d[2] = v[i].z; d[3] = v[i].w; }
    LDS_WAIT();
    const int c = lane & 7;
#pragma unroll
    for (int j = 0; j < 4; ++j) { const int n = (lane >> 3) + 8 * j; const LAS float* s = scr + (8 * c) * 33 + n;
        u32x4 o; o.x = pk2(s[0 * 33], s[1 * 33]); o.y = pk2(s[2 * 33], s[3 * 33]); o.z = pk2(s[4 * 33], s[5 * 33]); o.w = pk2(s[6 * 33], s[7 * 33]);
        *(u32x4*)(t.WT + (size_t)(t.dst0 + 32 * t.dnb + n) * t.K + 64 * t.kb + 8 * c) = o; }
    LDS_WAIT();
}
__device__ __forceinline__ TrItem tr_decode0(const KP P, unsigned char* ws, int r) {
    constexpr int I0 = 16 * 224, I1 = 16 * 64, I2 = 16 * 32;
    TrItem t; t.K = D;
    if (r < I0) { t.W = P->w_in; t.ldw = 9232; t.src0 = 0; t.WT = (bf16*)(ws + WS_WIN); t.dst0 = 0; t.kb = r / 224; t.nb = r % 224;
        t.dnb = t.nb; if (t.nb >= 32 && t.nb < 64) t.dnb = 32 + 8 * ((t.nb - 32) >> 2) + ((t.nb - 32) & 3); else if (t.nb >= 64 && t.nb < 96) t.dnb = 32 + 8 * ((t.nb - 64) >> 2) + 4 + ((t.nb - 64) & 3);
        return t; } r -= I0;
    if (r < I1) { t.W = P->w_in; t.ldw = 9232; t.src0 = 7184; t.WT = (bf16*)(ws + WS_WIN); t.dst0 = 7168; t.kb = r / 64; t.nb = r % 64; t.dnb = t.nb; return t; } r -= I1;
    t.ldw = D; t.src0 = 0; t.dst0 = 0;
    if (r < I2) { t.W = P->w_a_out; t.WT = (bf16*)(ws + WS_WA); } else if (r < 2 * I2) { t.W = P->w_b_out; t.WT = (bf16*)(ws + WS_WB); r -= I2; } else { t.W = P->w_o; t.WT = (bf16*)(ws + WS_WO); r -= 2 * I2; }
    t.kb = r / 32; t.nb = r % 32; t.dnb = t.nb; return t;
}
__device__ __forceinline__ TrItem tr_decode1(const KP P, unsigned char* ws, int r) {
    TrItem t; t.src0 = 0; t.dst0 = 0;
    if (r < 2048) { t.W = P->w_ff1; t.ldw = FF; t.K = D; t.WT = (bf16*)(ws + WS_WFF1); t.kb = r / 128; t.nb = r % 128; }
    else { r -= 2048; t.W = P->w_ff2; t.ldw = D; t.K = FF; t.WT = (bf16*)(ws + WS_WFF2); t.kb = r / 32; t.nb = r % 32; }
    t.dnb = t.nb; return t;
}

template <int MODE>
__device__ __forceinline__ void norm_phase(const KP P, unsigned char* ws, int gw, int NGW, int lane) {
    const float* g = MODE == 0 ? P->norm1_g : (MODE == 1 ? P->norm2_g : P->final_norm_g);
    const float* modb = (const float*)(ws + (MODE == 2 ? WS_MODF : WS_MOD));
    const int mstride = MODE == 2 ? 2048 : 6144, sco = MODE == 0 ? 1024 : (MODE == 1 ? 4096 : 1024), sho = MODE == 0 ? 0 : (MODE == 1 ? 3072 : 0);
    const float* xp = P->x_prompt; const float* xs = P->x_sample; float* outp = P->out;
    const bf16* part = (const bf16*)(ws + (MODE == 1 ? WS_R1 : WS_XN));
    bf16* xn = (bf16*)(ws + WS_XN);
#define NORM_BODY(v, r) do { \
        const float* mb = modb + (size_t)batch_of(r) * mstride; \
        f32x4 gg[4], ss[4], hh[4]; \
        _Pragma("unroll") for (int j = 0; j < 4; ++j) { const int c = lane * 4 + 256 * j; gg[j] = *(const f32x4*)(g + c); ss[j] = *(const f32x4*)(mb + sco + c); hh[j] = *(const f32x4*)(mb + sho + c); } \
        float s = 0.f; \
        _Pragma("unroll") for (int j = 0; j < 4; ++j) s += (v[j].x * v[j].x + v[j].y * v[j].y) + (v[j].z * v[j].z + v[j].w * v[j].w); \
        const float rstd = 1.f / sqrtf(wave_sum(s) * (1.f / D) + EPS); \
        _Pragma("unroll") for (int j = 0; j < 4; ++j) { \
            const int c = lane * 4 + 256 * j; \
            const f32x4 o = (v[j] * rstd) * gg[j] * (ss[j] + 1.f) + hh[j]; \
            if (MODE == 2) *(f32x4*)(outp + (size_t)(r) * D + c) = o; \
            else { u32x2 w; w.x = pk2(o.x, o.y); w.y = pk2(o.z, o.w); *(u32x2*)(xn + (size_t)(r) * D + c) = w; } \
        } } while (0)
    const float* src = MODE == 0 ? xp : outp;
    int r = gw; f32x4 nv[2][4];
#pragma unroll
    for (int u = 0; u < 2; ++u) if (r + u * NGW < MPROMPT) {
#pragma unroll
        for (int j = 0; j < 4; ++j) nv[u][j] = *(const f32x4*)(src + (size_t)(r + u * NGW) * D + lane * 4 + 256 * j); }
    for (; r < MPROMPT; r += 2 * NGW) {
        f32x4 v0[4], v1[4];
#pragma unroll
        for (int j = 0; j < 4; ++j) { v0[j] = nv[0][j]; v1[j] = nv[1][j]; }
#pragma unroll
        for (int u = 0; u < 2; ++u) { const int rn = r + (2 + u) * NGW; if (rn < MPROMPT) {
#pragma unroll
            for (int j = 0; j < 4; ++j) nv[u][j] = *(const f32x4*)(src + (size_t)rn * D + lane * 4 + 256 * j); } }
        NORM_BODY(v0, r);
        if (r + NGW < MPROMPT) { const int r1 = r + NGW; NORM_BODY(v1, r1); }
    }
    for (r = MPROMPT + gw; r < MTOK; r += NGW) {
        f32x4 v[4];
        const float* xr = MODE == 2 ? outp + (size_t)r * D : xs + (size_t)(r - MPROMPT) * D;
#pragma unroll
        for (int j = 0; j < 4; ++j) v[j] = *(const f32x4*)(xr + lane * 4 + 256 * j);
        if (MODE != 0) {
            u32x2 pw[8][4];
#pragma unroll
            for (int sl = 0; sl < 8; ++sl)
#pragma unroll
                for (int j = 0; j < 4; ++j) pw[sl][j] = *(const u32x2*)(part + ((size_t)sl * 2048 + (r - MPROMPT)) * D + lane * 4 + 256 * j);
#pragma unroll
            for (int sl = 0; sl < 8; ++sl)
#pragma unroll
                for (int j = 0; j < 4; ++j) { v[j].x += bflo(pw[sl][j].x); v[j].y += bfhi(pw[sl][j].x); v[j].z += bflo(pw[sl][j].y); v[j].w += bfhi(pw[sl][j].y); }
            if (MODE == 1) {
#pragma unroll
                for (int j = 0; j < 4; ++j) *(f32x4*)(outp + (size_t)r * D + lane * 4 + 256 * j) = v[j];
            }
        }
        NORM_BODY(v, r);
    }
#undef NORM_BODY
}

__global__ void __launch_bounds__(512, 2) mega_fwd(Params p) {
    extern __shared__ __attribute__((aligned(16))) unsigned char smem[];
    LAS unsigned char* lds = (LAS unsigned char*)smem;
    cg::grid_group grid = cg::this_grid();
    volatile LAS unsigned* xst = (volatile LAS unsigned*)(lds + LDS_BYTES - 16);
    if (threadIdx.x < 4) xst[threadIdx.x] = 0u;
    __syncthreads();
    const XcdBarrier xbar = xcd_barrier_post((unsigned*)(p.ws + WS_BAR), xst);
    if (gridDim.x == 0x7fffffffu) grid.sync();
#define PHASE_BEGIN const KP P = kp_get(); unsigned char* const ws = P->ws; (void)ws; \
    int tid = threadIdx.x; asm volatile("" : "+v"(tid)); const int lane = tid & 63, wave = __builtin_amdgcn_readfirstlane(tid >> 6); \
    int bid = blockIdx.x; asm volatile("" : "+s"(bid)); const int G = gridDim.x; const int gw = bid * 8 + wave, NGW = G * 8; (void)lane; (void)gw; (void)NGW;
#define mod ((float*)(ws + WS_MOD))
#define modf ((float*)(ws + WS_MODF))
#define XN ((bf16*)(ws + WS_XN))
#define R1 ((bf16*)(ws + WS_R1))
#define R2 ((bf16*)(ws + WS_R2))
#define R3 ((bf16*)(ws + WS_R3))
#define WIN ((bf16*)(ws + WS_WIN))
#define WA ((bf16*)(ws + WS_WA))
#define WB ((bf16*)(ws + WS_WB))
#define WO ((bf16*)(ws + WS_WO))
#define WFF1 ((bf16*)(ws + WS_WFF1))
#define WFF2 ((bf16*)(ws + WS_WFF2))
#define GLOG ((float*)(ws + WS_G))
#define BETA ((float*)(ws + WS_BETA))
#define GC ((float*)(ws + WS_GC))
#define HALO ((bf16*)(ws + WS_HALO))
#define ZB ((bf16*)P->out)
#define OB ((bf16*)((unsigned char*)P->out + 36 * MiB))
    const Epi E{};

    {
        PHASE_BEGIN
        LAS bf16* cs = (LAS bf16*)lds;
        for (int i = tid; i < NB * D / 4; i += 512) { const int r = i >> 8, k = (i & 255) * 4; const f32x4 c = *(const f32x4*)(r < 4 ? P->c_prompt + r * D + k : P->c_sample + (r - 4) * D + k);
            u32x2 w; w.x = pk2(c.x * __builtin_amdgcn_rcpf(1.f + __expf(-c.x)), c.y * __builtin_amdgcn_rcpf(1.f + __expf(-c.y))); w.y = pk2(c.z * __builtin_amdgcn_rcpf(1.f + __expf(-c.z)), c.w * __builtin_amdgcn_rcpf(1.f + __expf(-c.w)));
            *(LAS u32x2*)(cs + r * 1032 + k) = w; }
        __syncthreads();
        LAS float* scr = (LAS float*)(lds + 74304 + wave * 8448);
        {
            const int cg = 2 * bid + (wave >> 2), kq = wave & 3;
            int col0 = cg * 16; const float* W; const float* bias; float* outp; int ld;
            if (col0 < 6144) { W = P->ada_w; bias = P->ada_b; outp = mod; ld = 6144; } else { col0 -= 6144; W = P->final_ada_w; bias = P->final_ada_b; outp = modf; ld = 2048; }
            const int n = lane & 15, q = lane >> 4;
            f32x4 acc[3] = {{0.f, 0.f, 0.f, 0.f}, {0.f, 0.f, 0.f, 0.f}, {0.f, 0.f, 0.f, 0.f}};
            if (cg < 512) {
#pragma unroll 4
                for (int ks = 8 * kq; ks < 8 * kq + 8; ++ks) {
                    const float* wp = W + (size_t)(32 * ks + 8 * q) * ld + col0 + n;
                    float wv[8];
#pragma unroll
                    for (int j = 0; j < 8; ++j) wv[j] = wp[(size_t)j * ld];
                    u32x4 bw; bw.x = pk2(wv[0], wv[1]); bw.y = pk2(wv[2], wv[3]); bw.z = pk2(wv[4], wv[5]); bw.w = pk2(wv[6], wv[7]);
                    const bf16x8 bfrag = __builtin_bit_cast(bf16x8, bw);
#pragma unroll
                    for (int mt = 0; mt < 3; ++mt) {
                        const int row = 16 * mt + n;
                        bf16x8 afrag = {0, 0, 0, 0, 0, 0, 0, 0};
                        if (row < NB) afrag = *(const LAS bf16x8*)(cs + row * 1032 + 32 * ks + 8 * q);
                        acc[mt] = __builtin_amdgcn_mfma_f32_16x16x32_bf16(afrag, bfrag, acc[mt], 0, 0, 0);
                    }
                }
            }
#pragma unroll
            for (int mt = 0; mt < 3; ++mt) *(LAS f32x4*)(scr + (mt * 64 + lane) * 4) = acc[mt];
            __syncthreads();
            if (kq == 0 && cg < 512) {
                const float bv = bias[col0 + n];
#pragma unroll
                for (int mt = 0; mt < 3; ++mt) {
                    f32x4 t = acc[mt];
#pragma unroll
                    for (int w2 = 1; w2 < 4; ++w2) t += *(const LAS f32x4*)((LAS float*)(lds + 74304 + (wave + w2) * 8448) + (mt * 64 + lane) * 4);
#pragma unroll
                    for (int jj = 0; jj < 4; ++jj) { const int row = 16 * mt + 4 * q + jj; if (row < NB) outp[(size_t)row * ld + col0 + n] = t[jj] + bv; }
                }
            }
            __syncthreads();
        }
        constexpr int NT = 16 * 224 + 16 * 64 + 3 * 16 * 32;
        for (int base = gw; base < NT; base += 3 * NGW) {
            TrItem t0 = tr_decode0(P, ws, base), t1 = t0, t2 = t0; f32x4 v0[8], v1[8], v2[8];
            const bool h1 = base + NGW < NT, h2 = base + 2 * NGW < NT;
            transpose_load(t0, v0, lane);
            if (h1) { t1 = tr_decode0(P, ws, base + NGW); transpose_load(t1, v1, lane); }
            if (h2) { t2 = tr_decode0(P, ws, base + 2 * NGW); transpose_load(t2, v2, lane); }
            transpose_finish(t0, v0, scr, lane);
            if (h1) transpose_finish(t1, v1, scr, lane);
            if (h2) transpose_finish(t2, v2, scr, lane);
        }
        if (gw == NGW - 1) {
            for (int e = lane; e < 16 * D; e += 64) { const int n = e >> 10, k = e & 1023; WIN[(size_t)(9216 + n) * D + k] = (bf16)f2bf(P->w_in[(size_t)k * 9232 + 7168 + n]); }
        }
    }
    xcd_barrier(xbar);

    { PHASE_BEGIN
      norm_phase<0>(P, ws, gw, NGW, lane); }
    xcd_barrier(xbar);

    {
        PHASE_BEGIN
        SchedP2 S; S.XNp = XN; S.Bp = WIN; S.Bz = WIN + (size_t)6144 * D; S.c = bid;
        pg8::gemm_phase(lds, D, D, S, E);
    }
    xcd_barrier(xbar);

    { PHASE_BEGIN
    for (int idx = bid * 512 + tid; idx < MTOK * 128; idx += G * 512) {
        const int r = idx >> 7, c8 = (idx & 127) * 8;
        const bool prm = r < MPROMPT; const int tpos = prm ? (r & 4095) : ((r - MPROMPT) & 63); const int T = prm ? 4096 : 64; const int bs = prm ? (r >> 12) : ((r - MPROMPT) >> 6);
        const bf16* row = R1 + (size_t)r * 3072 + c8;
        const u32x4 pb = *(const u32x4*)row, uv0 = *(const u32x4*)(row + 1024);
        float u0[8], u1[8], u2[8];
#define P3_UNPK(U_, W_) do { U_[0] = bflo(W_.x); U_[1] = bfhi(W_.x); U_[2] = bflo(W_.y); U_[3] = bfhi(W_.y); U_[4] = bflo(W_.z); U_[5] = bfhi(W_.z); U_[6] = bflo(W_.w); U_[7] = bfhi(W_.w); } while (0)
        P3_UNPK(u0, uv0);
        if (tpos >= 1) { const u32x4 w1 = *(const u32x4*)(row - 3072 + 1024); P3_UNPK(u1, w1); }
        else {
#pragma unroll
            for (int e = 0; e < 8; ++e) u1[e] = prm ? 0.f : P->cache_conv_a[((size_t)bs * 2 + 1) * D + c8 + e];
        }
        if (tpos >= 2) { const u32x4 w2 = *(const u32x4*)(row - 6144 + 1024); P3_UNPK(u2, w2); }
        else {
#pragma unroll
            for (int e = 0; e < 8; ++e) u2[e] = prm ? 0.f : P->cache_conv_a[((size_t)bs * 2 + tpos) * D + c8 + e];
        }
#undef P3_UNPK
        float y[8];
#pragma unroll
        for (int e = 0; e < 8; ++e) y[e] = P->conv_a_w[c8 + e] * u2[e] + P->conv_a_w[D + c8 + e] * u1[e] + P->conv_a_w[2 * D + c8 + e] * u0[e];
        u32x4 o; o.x = pk2(bflo(pb.x) * y[0], bfhi(pb.x) * y[1]); o.y = pk2(bflo(pb.y) * y[2], bfhi(pb.y) * y[3]);
        o.z = pk2(bflo(pb.z) * y[4], bfhi(pb.z) * y[5]); o.w = pk2(bflo(pb.w) * y[6], bfhi(pb.w) * y[7]);
        *(u32x4*)(R2 + (size_t)r * D + c8) = o;
        if (tpos >= T - 2) {
            float* dst = P->out + (prm ? O_CONVA_P : O_CONVA_S) + ((size_t)bs * 2 + (tpos - (T - 2))) * D + c8;
            *(f32x4*)dst = (f32x4){u0[0], u0[1], u0[2], u0[3]}; *(f32x4*)(dst + 4) = (f32x4){u0[4], u0[5], u0[6], u0[7]};
        }
    } }
    xcd_barrier(xbar);

    {
        PHASE_BEGIN
        SchedP4 S; S.XNp = XN; S.Bqkv = WIN + (size_t)3072 * D; S.Bab = WIN + (size_t)9216 * D; S.YAp = R2; S.Bya = WA; S.Bz = WIN + (size_t)6144 * D; S.c = bid;
        pg8::gemm_phase(lds, D, D, S, E);
    }
    xcd_barrier(xbar);

    { PHASE_BEGIN
    for (int it = gw; it < NCHUNK * 24; it += NGW) {
        const int cidx = it / 24, s = it % 24, part = s >> 3;
        const int col = s * 128 + 2 * lane;
        const bool prm = cidx < 256; const int bs = prm ? (cidx >> 6) : (cidx - 256);
        const bool first = prm ? ((cidx & 63) == 0) : true; const bool lastc = prm ? ((cidx & 63) == 63) : true;
        float xa[3], xb[3];
#pragma unroll
        for (int j = 0; j < 3; ++j) {
            if (!first) { const unsigned w = *(const unsigned*)(HALO + ((size_t)(cidx - 1) * 3 + j) * 3072 + col); xa[j] = bflo(w); xb[j] = bfhi(w); }
            else if (prm) { xa[j] = 0.f; xb[j] = 0.f; }
            else { const float* cp = P->cache_conv_qkv + ((size_t)bs * 3 + j) * 3072 + col; xa[j] = cp[0]; xb[j] = cp[1]; }
        }
        float wa[4], wb[4];
#pragma unroll
        for (int j = 0; j < 4; ++j) { wa[j] = P->conv_qkv_w[(size_t)j * 3072 + col]; wb[j] = P->conv_qkv_w[(size_t)j * 3072 + col + 1]; }
        bf16* base = R1 + (size_t)cidx * 64 * 3072 + col;
        const float qs = part == 0 ? 0.08838834764831845f : 1.f;
#pragma unroll
        for (int hb = 0; hb < 2; ++hb) {
            unsigned xv[32];
#pragma unroll
            for (int t = 0; t < 32; ++t) xv[t] = *(const unsigned*)(base + (size_t)(hb * 32 + t) * 3072);
#pragma unroll
            for (int t = 0; t < 32; ++t) {
                const float x0 = bflo(xv[t]), x1 = bfhi(xv[t]);
                const float y0 = wa[0] * xa[0] + wa[1] * xa[1] + wa[2] * xa[2] + wa[3] * x0;
                const float y1 = wb[0] * xb[0] + wb[1] * xb[1] + wb[2] * xb[2] + wb[3] * x1;
                xa[0] = xa[1]; xa[1] = xa[2]; xa[2] = x0; xb[0] = xb[1]; xb[1] = xb[2]; xb[2] = x1;
                float s0 = y0 * __builtin_amdgcn_rcpf(1.f + __expf(-y0)), s1 = y1 * __builtin_amdgcn_rcpf(1.f + __expf(-y1));
                if (part < 2) { const float ss = wave_sum(s0 * s0 + s1 * s1); const float sc = qs * __builtin_amdgcn_rsqf(ss + EPS); s0 *= sc; s1 *= sc; }
                *(unsigned*)(base + (size_t)(hb * 32 + t) * 3072) = pk2(s0, s1);
            }
        }
        if (lastc) {
            float* dst = P->out + (prm ? O_CONVQ_P : O_CONVQ_S) + (size_t)bs * 3 * 3072 + col;
#pragma unroll
            for (int j = 0; j < 3; ++j) { dst[(size_t)j * 3072] = xa[j]; dst[(size_t)j * 3072 + 1] = xb[j]; }
        }
    } }
    xcd_barrier(xbar);

    {
        PHASE_BEGIN
        LAS float* Am = (LAS float*)(lds + wave * 16896);
        LAS float* gcs = Am + 4096;
        LAS float* bts = gcs + 64;
        bf16* TP = R2; bf16* QKM = R2 + (size_t)NCHUNK * 8 * 4096;
        const int n = lane & 15, q = lane >> 4;
#pragma unroll 1
        for (int rnd = 0; rnd < 2; ++rnd) {
            const int it = rnd == 0 ? gw : (wave == 0 ? 2048 + bid : 1 << 30);
            if (it >= NCHUNK * 8) continue;
            const int cidx = it >> 3, h = it & 7; const int r0 = cidx * 64;
            float gv = GLOG[(size_t)(r0 + lane) * 8 + h]; const float bt = BETA[(size_t)(r0 + lane) * 8 + h];
#pragma unroll
            for (int o = 1; o < 64; o <<= 1) { const float t = __shfl_up(gv, o); if (lane >= o) gv += t; }
            gcs[lane] = gv; bts[lane] = bt; GC[(size_t)it * 64 + lane] = gv;
            LDS_WAIT();
            const bf16* qb = R1 + (size_t)r0 * 3072 + h * 128; const bf16* kb = qb + 1024;
            bf16x8 kf[4][4];
#pragma unroll
            for (int mt = 0; mt < 4; ++mt)
#pragma unroll
                for (int ks = 0; ks < 4; ++ks) kf[mt][ks] = *(const bf16x8*)(kb + (size_t)(16 * mt + n) * 3072 + 32 * ks + 8 * q);
#pragma unroll
            for (int mi = 0; mi < 4; ++mi)
#pragma unroll
                for (int nj = 0; nj < 4; ++nj) {
                    f32x4 c = {0.f, 0.f, 0.f, 0.f};
#pragma unroll
                    for (int ks = 0; ks < 4; ++ks) c = __builtin_amdgcn_mfma_f32_16x16x32_bf16(kf[mi][ks], kf[nj][ks], c, 0, 0, 0);
                    const int j = 16 * nj + n; const float gj = gcs[j];
#pragma unroll
                    for (int jj = 0; jj < 4; ++jj) { const int i = 16 * mi + 4 * q + jj; const float v = (i > j) ? bts[i] * c[jj] * __expf(gcs[i] - gj) : 0.f; Am[i * 64 + j] = v; }
                }
            {
#pragma unroll
                for (int mi = 0; mi < 4; ++mi) {
                    bf16x8 qf[4];
#pragma unroll
                    for (int ks = 0; ks < 4; ++ks) qf[ks] = *(const bf16x8*)(qb + (size_t)(16 * mi + n) * 3072 + 32 * ks + 8 * q);
#pragma unroll
                    for (int nj = 0; nj < 4; ++nj) {
                        f32x4 c = {0.f, 0.f, 0.f, 0.f};
#pragma unroll
                        for (int ks = 0; ks < 4; ++ks) c = __builtin_amdgcn_mfma_f32_16x16x32_bf16(qf[ks], kf[nj][ks], c, 0, 0, 0);
                        const int j = 16 * nj + n; const float gj = gcs[j];
#pragma unroll
                        for (int jj = 0; jj < 4; ++jj) { const int i = 16 * mi + 4 * q + jj; const float v = (i >= j) ? c[jj] * __expf(gcs[i] - gj) : 0.f; QKM[(size_t)it * 4096 + i * 64 + j] = (bf16)f2bf(v); }
                    }
                }
            }
            LDS_WAIT();
            float Tc[64];
#pragma unroll
            for (int i = 0; i < 64; ++i) {
                float s = (lane == i) ? 1.f : 0.f;
#pragma unroll
                for (int j4 = 0; j4 < (i + 3) / 4; ++j4) {
                    const f32x4 a = *(const LAS f32x4*)(Am + i * 64 + j4 * 4);
                    if (j4 * 4 + 0 < i) s -= a.x * Tc[j4 * 4 + 0];
                    if (j4 * 4 + 1 < i) s -= a.y * Tc[j4 * 4 + 1];
                    if (j4 * 4 + 2 < i) s -= a.z * Tc[j4 * 4 + 2];
                    if (j4 * 4 + 3 < i) s -= a.w * Tc[j4 * 4 + 3];
                }
                Tc[i] = s;
            }
#pragma unroll
            for (int i = 0; i < 64; ++i) TP[(size_t)it * 4096 + i * 64 + lane] = (bf16)f2bf(Tc[i] * bt);
            LDS_WAIT();
        }
    }
    xcd_barrier(xbar);

    {
        PHASE_BEGIN
        constexpr int LKG = 0, LQD = 17408, LKDT = 34816, LTP = 53248, LQK = 62464, LST = 71680, LXT = 80384, LVL = 84992, LGL = 90112;
        LAS bf16* Kg = (LAS bf16*)(lds + LKG);
        LAS bf16* Qd = (LAS bf16*)(lds + LQD);
        LAS bf16* KdT = (LAS bf16*)(lds + LKDT);
        LAS bf16* Tp = (LAS bf16*)(lds + LTP);
        LAS bf16* Qk = (LAS bf16*)(lds + LQK);
        LAS bf16* ST = (LAS bf16*)(lds + LST);
        LAS bf16* XT = (LAS bf16*)(lds + LXT);
        LAS bf16* VL = (LAS bf16*)(lds + LVL);
        LAS float* GLw = (LAS float*)(lds + LGL);
        const bf16* TPg = R2; const bf16* QKMg = R2 + (size_t)NCHUNK * 8 * 4096;
        const int n = lane & 15, q = lane >> 4, vl = 16 * (wave & 1) + n;
        const bool cw = wave < 2;
        const int sid = tid - 128;
        const bool two = sid < 128;
#define LBAR() do { asm volatile("s_waitcnt lgkmcnt(0)" ::: "memory"); __builtin_amdgcn_s_barrier(); asm volatile("" ::: "memory"); } while (0)
        int task, tstep;
        if (bid < 128) { task = bid; tstep = 1 << 30; } else { task = 128 + (bid - 128); tstep = G - 128; }
        for (; task < 1152; task += tstep) {
            const bool prm = task < 128; const int tt = prm ? task : task - 128;
            const int c7 = tt & 127, st = (tt & ~127) / 4 + (c7 & 7) * 4 + (c7 >> 5), vq = (c7 >> 3) & 3;
            const int b = st >> 3, h = st & 7;
            const int nch = prm ? 64 : 1; const int cidx0 = prm ? b * 64 : 256 + b;
            const int v = vq * 32 + vl;
            f32x4 Sacc[8];
            if (cw) {
#pragma unroll
                for (int kt = 0; kt < 8; ++kt) {
                    if (prm) Sacc[kt] = (f32x4){0.f, 0.f, 0.f, 0.f};
                    else {
#pragma unroll
                        for (int jj = 0; jj < 4; ++jj) Sacc[kt][jj] = P->state_delta[(((size_t)b * 8 + h) * 128 + 16 * kt + 4 * q + jj) * 128 + v];
                    }
                    u32x2 w; w.x = pk2(Sacc[kt][0], Sacc[kt][1]); w.y = pk2(Sacc[kt][2], Sacc[kt][3]);
                    *(LAS u32x2*)(ST + vl * 136 + 16 * kt + 4 * q) = w;
                }
            }
            u32x4 pq0[2], pq1[2], ptp[2], pqk[2], pvv; unsigned pkw[2][8]; float pgt[2], pgl;
#define SCAN_PREFETCH(cidx_) do { const int r0_ = (cidx_) * 64; const size_t ci_ = (size_t)(cidx_) * 8 + h; \
            _Pragma("unroll") for (int p_ = 0; p_ < 2; ++p_) if (p_ == 0 || two) { const int it_ = sid + 384 * p_, t_ = it_ >> 3, kg_ = it_ & 7; \
                const bf16* qrow_ = R1 + (size_t)(r0_ + t_) * 3072 + h * 128; \
                pq0[p_] = *(const u32x4*)(qrow_ + kg_ * 16); pq1[p_] = *(const u32x4*)(qrow_ + kg_ * 16 + 8); \
                _Pragma("unroll") for (int e_ = 0; e_ < 8; ++e_) pkw[p_][e_] = *(const unsigned*)(qrow_ + 1024 + 2 * kg_ + 16 * e_); \
                ptp[p_] = *(const u32x4*)(TPg + ci_ * 4096 + t_ * 64 + kg_ * 8); pqk[p_] = *(const u32x4*)(QKMg + ci_ * 4096 + t_ * 64 + kg_ * 8); \
                pgt[p_] = GC[ci_ * 64 + t_]; } \
            pgl = GC[ci_ * 64 + 63]; \
            if (sid < 256) pvv = *(const u32x4*)(R1 + (size_t)(r0_ + (sid >> 2)) * 3072 + 2048 + h * 128 + vq * 32 + (sid & 3) * 8); } while (0)
            if (!cw) SCAN_PREFETCH(cidx0);
            for (int ch = 0; ch < nch; ++ch) {
                const int cidx = cidx0 + ch; const int r0 = cidx * 64;
                LBAR();
                if (!cw) {
#pragma unroll
                    for (int p = 0; p < 2; ++p) if (p == 0 || two) {
                        const int it = sid + 384 * p, t = it >> 3, kg = it & 7;
                        const float eg = __expf(pgt[p]), ed = __expf(pgl - pgt[p]);
                        u32x4 o;
                        o.x = pk2(bflo(pq0[p].x) * eg, bfhi(pq0[p].x) * eg); o.y = pk2(bflo(pq0[p].y) * eg, bfhi(pq0[p].y) * eg); o.z = pk2(bflo(pq0[p].z) * eg, bfhi(pq0[p].z) * eg); o.w = pk2(bflo(pq0[p].w) * eg, bfhi(pq0[p].w) * eg);
                        *(LAS u32x4*)(Qd + t * 136 + kg * 16) = o;
                        o.x = pk2(bflo(pq1[p].x) * eg, bfhi(pq1[p].x) * eg); o.y = pk2(bflo(pq1[p].y) * eg, bfhi(pq1[p].y) * eg); o.z = pk2(bflo(pq1[p].z) * eg, bfhi(pq1[p].z) * eg); o.w = pk2(bflo(pq1[p].w) * eg, bfhi(pq1[p].w) * eg);
                        *(LAS u32x4*)(Qd + t * 136 + kg * 16 + 8) = o;
#pragma unroll
                        for (int e = 0; e < 8; ++e) {
                            const int k = 2 * kg + 16 * e; const float lo = bflo(pkw[p][e]), hi = bfhi(pkw[p][e]);
                            *(LAS unsigned*)(Kg + t * 136 + k) = pk2(lo * eg, hi * eg);
                            KdT[k * 72 + t] = (bf16)f2bf(lo * ed); KdT[(k + 1) * 72 + t] = (bf16)f2bf(hi * ed);
                        }
                        *(LAS u32x4*)(Tp + t * 72 + kg * 8) = ptp[p];
                        *(LAS u32x4*)(Qk + t * 72 + kg * 8) = pqk[p];
                    }
                    if (sid < 256) *(LAS u32x4*)(VL + (sid >> 2) * 40 + (sid & 3) * 8) = pvv;
                    if (sid == 0) GLw[0] = __expf(pgl);
                }
                LBAR();
                if (!cw) { if (ch + 1 < nch) SCAN_PREFETCH(cidx + 1); }
                else {
                    const float gl = GLw[0];
                    f32x4 vt[4];
#pragma unroll
                    for (int mt = 0; mt < 4; ++mt)
#pragma unroll
                        for (int jj = 0; jj < 4; ++jj) vt[mt][jj] = bf2f(VL[(16 * mt + 4 * q + jj) * 40 + vl]);
                    f32x4 acc[4] = {{0.f, 0.f, 0.f, 0.f}, {0.f, 0.f, 0.f, 0.f}, {0.f, 0.f, 0.f, 0.f}, {0.f, 0.f, 0.f, 0.f}};
                    bf16x8 sfr[4];
#pragma unroll
                    for (int ks = 0; ks < 4; ++ks) sfr[ks] = *(const LAS bf16x8*)(ST + vl * 136 + 32 * ks + 8 * q);
#pragma unroll
                    for (int mt = 0; mt < 4; ++mt)
#pragma unroll
                        for (int ks = 0; ks < 4; ++ks) {
                            const bf16x8 a = *(const LAS bf16x8*)(Kg + (16 * mt + n) * 136 + 32 * ks + 8 * q);
                            acc[mt] = __builtin_amdgcn_mfma_f32_16x16x32_bf16(a, sfr[ks], acc[mt], 0, 0, 0);
                        }
#pragma unroll
                    for (int mt = 0; mt < 4; ++mt) { const f32x4 d = vt[mt] - acc[mt]; u32x2 w; w.x = pk2(d[0], d[1]); w.y = pk2(d[2], d[3]); *(LAS u32x2*)(XT + vl * 72 + 16 * mt + 4 * q) = w; }
                    f32x4 vn[4] = {{0.f, 0.f, 0.f, 0.f}, {0.f, 0.f, 0.f, 0.f}, {0.f, 0.f, 0.f, 0.f}, {0.f, 0.f, 0.f, 0.f}};
                    bf16x8 xf[2];
#pragma unroll
                    for (int ks = 0; ks < 2; ++ks) xf[ks] = *(const LAS bf16x8*)(XT + vl * 72 + 32 * ks + 8 * q);
#pragma unroll
                    for (int mt = 0; mt < 4; ++mt)
#pragma unroll
                        for (int ks = 0; ks < 2; ++ks) {
                            const bf16x8 a = *(const LAS bf16x8*)(Tp + (16 * mt + n) * 72 + 32 * ks + 8 * q);
                            vn[mt] = __builtin_amdgcn_mfma_f32_16x16x32_bf16(a, xf[ks], vn[mt], 0, 0, 0);
                        }
#pragma unroll
                    for (int mt = 0; mt < 4; ++mt) { u32x2 w; w.x = pk2(vn[mt][0], vn[mt][1]); w.y = pk2(vn[mt][2], vn[mt][3]); *(LAS u32x2*)(XT + vl * 72 + 16 * mt + 4 * q) = w; }
#pragma unroll
                    for (int ks = 0; ks < 2; ++ks) xf[ks] = *(const LAS bf16x8*)(XT + vl * 72 + 32 * ks + 8 * q);
#pragma unroll
                    for (int kt = 0; kt < 8; ++kt) {
                        Sacc[kt] = Sacc[kt] * gl;
#pragma unroll
                        for (int ks = 0; ks < 2; ++ks) {
                            const bf16x8 a = *(const LAS bf16x8*)(KdT + (16 * kt + n) * 72 + 32 * ks + 8 * q);
                            Sacc[kt] = __builtin_amdgcn_mfma_f32_16x16x32_bf16(a, xf[ks], Sacc[kt], 0, 0, 0);
                        }
                        u32x2 w; w.x = pk2(Sacc[kt][0], Sacc[kt][1]); w.y = pk2(Sacc[kt][2], Sacc[kt][3]);
                        *(LAS u32x2*)(ST + vl * 136 + 16 * kt + 4 * q) = w;
                    }
                    f32x4 oo[4] = {{0.f, 0.f, 0.f, 0.f}, {0.f, 0.f, 0.f, 0.f}, {0.f, 0.f, 0.f, 0.f}, {0.f, 0.f, 0.f, 0.f}};
#pragma unroll
                    for (int mt = 0; mt < 4; ++mt) {
#pragma unroll
                        for (int ks = 0; ks < 4; ++ks) {
                            const bf16x8 a = *(const LAS bf16x8*)(Qd + (16 * mt + n) * 136 + 32 * ks + 8 * q);
                            oo[mt] = __builtin_amdgcn_mfma_f32_16x16x32_bf16(a, sfr[ks], oo[mt], 0, 0, 0);
                        }
#pragma unroll
                        for (int ks = 0; ks < 2; ++ks) {
                            const bf16x8 a = *(const LAS bf16x8*)(Qk + (16 * mt + n) * 72 + 32 * ks + 8 * q);
                            oo[mt] = __builtin_amdgcn_mfma_f32_16x16x32_bf16(a, xf[ks], oo[mt], 0, 0, 0);
                        }
                    }
#pragma unroll
                    for (int mt = 0; mt < 4; ++mt)
#pragma unroll
                        for (int jj = 0; jj < 4; ++jj) OB[(size_t)(r0 + 16 * mt + 4 * q + jj) * D + h * 128 + v] = (bf16)f2bf(oo[mt][jj]);
                }
            }
            if (cw) {
                float* dsto = P->out + (prm ? O_DELTA_P : O_DELTA_S) + ((size_t)b * 8 + h) * 16384;
#pragma unroll
                for (int kt = 0; kt < 8; ++kt)
#pragma unroll
                    for (int jj = 0; jj < 4; ++jj) dsto[(size_t)(16 * kt + 4 * q + jj) * 128 + v] = Sacc[kt][jj];
            }
        }
#undef SCAN_PREFETCH
        if (bid >= 128) {
            LBAR();
            SchedScanG S; S.XNp = XN; S.Bz = WIN + (size_t)6144 * D; S.Bgb = WIN + (size_t)8192 * D; S.Bga = WIN + (size_t)7168 * D; S.c = bid - 128;
            pg8::gemm_phase(lds, D, D, S, E);
        }
    }
    xcd_barrier(xbar);

    {
        PHASE_BEGIN
        for (int r = gw; r < MTOK; r += NGW) {
#pragma unroll
            for (int hf = 0; hf < 2; ++hf) {
                const size_t o = (size_t)r * D + hf * 512 + lane * 8;
                const u32x4 ov = *(const u32x4*)(OB + o), zv = *(const u32x4*)(ZB + o);
                float x[8] = {bflo(ov.x), bfhi(ov.x), bflo(ov.y), bfhi(ov.y), bflo(ov.z), bfhi(ov.z), bflo(ov.w), bfhi(ov.w)};
                const float z[8] = {bflo(zv.x), bfhi(zv.x), bflo(zv.y), bfhi(zv.y), bflo(zv.z), bfhi(zv.z), bflo(zv.w), bfhi(zv.w)};
                float s = 0.f;
#pragma unroll
                for (int e = 0; e < 8; ++e) s += x[e] * x[e];
                s = row16_sum(s);
                const float rs = __builtin_amdgcn_rsqf(s * (1.f / 128.f) + EPS);
                const float* gp = P->out_norm_g + (lane & 15) * 8;
                const f32x4 g0 = *(const f32x4*)gp, g1 = *(const f32x4*)(gp + 4);
                u32x4 w;
                w.x = pk2(x[0] * rs * g0[0] * z[0], x[1] * rs * g0[1] * z[1]); w.y = pk2(x[2] * rs * g0[2] * z[2], x[3] * rs * g0[3] * z[3]);
                w.z = pk2(x[4] * rs * g1[0] * z[4], x[5] * rs * g1[1] * z[5]); w.w = pk2(x[6] * rs * g1[2] * z[6], x[7] * rs * g1[3] * z[7]);
                *(u32x4*)(OB + o) = w;
            }
        }
    }
    xcd_barrier(xbar);

    {
        PHASE_BEGIN
        SchedPair64 SP; SP.A0 = OB; SP.B0 = WB; SP.k0 = K_YB; SP.A1 = XN; SP.B1 = WIN + (size_t)8192 * D; SP.k1 = K_GB; SP.G = G; SP.c = bid;
        pg8::gemm_phase(lds, D, D, SP, E);
        SchedSlice T; T.A = OB; T.B = WB; T.kind = K_YBS; T.G = G; T.c = bid; T.ld = D; T.ks = 128;
        pg8::gemm_phase(lds, 128, D, T, E);
    }
    xcd_barrier(xbar);
    {
        PHASE_BEGIN
        for (int i = bid * 512 + tid; i < 2048 * D / 8; i += G * 512) {
            bf16* ym = R3 + (size_t)MPROMPT * D + (size_t)i * 8;
            u32x4 pw[8];
#pragma unroll
            for (int sl = 0; sl < 8; ++sl) pw[sl] = *(const u32x4*)(R1 + (size_t)sl * 2048 * D + (size_t)i * 8);
            const u32x4 y = *(const u32x4*)ym;
            float a[8] = {bflo(y.x), bfhi(y.x), bflo(y.y), bfhi(y.y), bflo(y.z), bfhi(y.z), bflo(y.w), bfhi(y.w)};
#pragma unroll
            for (int sl = 0; sl < 8; ++sl) { a[0] += bflo(pw[sl].x); a[1] += bfhi(pw[sl].x); a[2] += bflo(pw[sl].y); a[3] += bfhi(pw[sl].y); a[4] += bflo(pw[sl].z); a[5] += bfhi(pw[sl].z); a[6] += bflo(pw[sl].w); a[7] += bfhi(pw[sl].w); }
            u32x4 w; w.x = pk2(a[0], a[1]); w.y = pk2(a[2], a[3]); w.z = pk2(a[4], a[5]); w.w = pk2(a[6], a[7]);
            *(u32x4*)ym = w;
        }
    }
    xcd_barrier(xbar);

    {
        PHASE_BEGIN
        SchedFull64 S; S.A = R3; S.B = WO; S.kind = K_O; S.G = G; S.c = bid; S.ld = D;
        pg8::gemm_phase(lds, D, D, S, E);
        SchedSlice T; T.A = R3; T.B = WO; T.kind = K_OS; T.G = G; T.c = bid; T.ld = D; T.ks = 128;
        pg8::gemm_phase(lds, 128, D, T, E);
    }
    xcd_barrier(xbar);

    {
        PHASE_BEGIN
        norm_phase<1>(P, ws, gw, NGW, lane);
        LAS float* scr = (LAS float*)(lds + wave * 8448);
        for (int base = gw; base < 4096; base += 2 * NGW) {
            TrItem t0 = tr_decode1(P, ws, base), t1 = t0; f32x4 v0[8], v1[8];
            const bool h1 = base + NGW < 4096;
            transpose_load(t0, v0, lane);
            if (h1) { t1 = tr_decode1(P, ws, base + NGW); transpose_load(t1, v1, lane); }
            transpose_finish(t0, v0, scr, lane);
            if (h1) transpose_finish(t1, v1, scr, lane);
        }
    }
    xcd_barrier(xbar);

    {
        PHASE_BEGIN
        SchedFlat S; S.A0 = S.A1 = S.A2 = XN; S.B0 = S.B1 = S.B2 = WFF1; S.n0 = 16; S.n1 = 0; S.n2 = 0; S.k0 = S.k1 = S.k2 = K_FF1; S.nN = 16; S.G = G; S.c = bid; S.K = D;
        pg8::gemm_phase(lds, D, D, S, E);
    }
    xcd_barrier(xbar);

    {
        PHASE_BEGIN
        SchedFull64 S; S.A = R1; S.B = WFF2; S.kind = K_FF2; S.G = G; S.c = bid; S.ld = FF;
        pg8::gemm_phase(lds, FF, FF, S, E);
        SchedSlice T; T.A = R1; T.B = WFF2; T.kind = K_FF2S; T.G = G; T.c = bid; T.ld = FF; T.ks = 512;
        pg8::gemm_phase(lds, 512, FF, T, E);
    }
    xcd_barrier(xbar);

    { PHASE_BEGIN
      norm_phase<2>(P, ws, gw, NGW, lane); }
}

extern "C" void kernel_launch(void* const* d_in, const int* in_sizes, int n_in, void* d_out, int out_size, void* d_ws, size_t ws_size, hipStream_t stream) {
    static int grid_blocks = 0;
    if (grid_blocks == 0) {
        if (n_in != 25 || ws_size < WS_END) { fprintf(stderr, "kernel_launch: unexpected n_in %d / ws_size %zu\n", n_in, ws_size); grid_blocks = -1; return; }
        int dev = 0, cus = 0, per_cu = 0;
        hipGetDevice(&dev);
        hipDeviceGetAttribute(&cus, hipDeviceAttributeMultiprocessorCount, dev);
        if (hipFuncSetAttribute((const void*)mega_fwd, hipFuncAttributeMaxDynamicSharedMemorySize, LDS_BYTES) != hipSuccess) { fprintf(stderr, "kernel_launch: hipFuncSetAttribute failed\n"); grid_blocks = -1; return; }
        hipOccupancyMaxActiveBlocksPerMultiprocessor(&per_cu, (const void*)mega_fwd, 512, LDS_BYTES);
        if (per_cu < 1) { fprintf(stderr, "kernel_launch: occupancy query gave %d\n", per_cu); per_cu = 1; }
        (void)hipGetLastError();
        grid_blocks = cus;
        if (cus != 256) { fprintf(stderr, "kernel_launch: the unit schedules are written for 256 CUs, found %d\n", cus); grid_blocks = -1; return; }
        fprintf(stderr, "kernel_launch: grid %d (per_cu %d), ws %zu\n", grid_blocks, per_cu, ws_size);
    }
    if (grid_blocks < 0) return;
    Params p{};
    const float** pp = (const float**)&p;
    for (int i = 0; i < 25; ++i) pp[i] = (const float*)d_in[i];
    p.out = (float*)d_out; p.ws = (unsigned char*)d_ws;
    if (hipMemsetAsync((char*)d_ws + WS_BAR, 0, BAR_BYTES, stream) != hipSuccess) { fprintf(stderr, "kernel_launch: memset of the barrier words failed\n"); return; }
    void* args[] = {&p};
    hipError_t e = hipLaunchCooperativeKernel((const void*)mega_fwd, dim3(grid_blocks), dim3(512), args, LDS_BYTES, stream);
    if (e != hipSuccess) fprintf(stderr, "cooperative launch failed: %s (grid %d)\n", hipGetErrorString(e), grid_blocks);
}
```

```cpp
#include <hip/hip_runtime.h>
#include <hip/hip_cooperative_groups.h>
#include <cstdio>
#include <cstdint>
namespace cg = cooperative_groups;

#define LAS __attribute__((address_space(3)))
typedef unsigned short bf16;
typedef short bf16x8 __attribute__((ext_vector_type(8)));
typedef float f32x4 __attribute__((ext_vector_type(4)));
typedef unsigned u32x4 __attribute__((ext_vector_type(4)));
typedef unsigned u32x2 __attribute__((ext_vector_type(2)));

constexpr int D = 1024, MTOK = 18432, MPROMPT = 16384, NB = 36, FF = 4096;
constexpr int NCHUNK = 288;
constexpr float EPS = 1e-6f;
constexpr size_t MiB = 1u << 20;
constexpr size_t WS_MOD = 0, WS_MODF = 1 * MiB, WS_G = 2 * MiB, WS_BETA = 3 * MiB, WS_HALO = 4 * MiB, WS_GC = 10 * MiB, WS_BAR = 11 * MiB, BAR_BYTES = 16384;
constexpr size_t WS_WIN = 12 * MiB, WS_WA = 31 * MiB, WS_WB = 33 * MiB, WS_WO = 35 * MiB;
constexpr size_t WS_XN = 38 * MiB, WS_R3 = 74 * MiB, WS_R1 = 110 * MiB, WS_R2 = 218 * MiB, WS_END = 254 * MiB;
constexpr size_t WS_WFF1 = WS_R3, WS_WFF2 = WS_R3 + 8 * MiB;
constexpr int LDS_BYTES = 147456;
constexpr size_t O_CONVA_P = 18874368, O_CONVQ_P = 18882560, O_DELTA_P = 18919424, O_CONVA_S = 19443712, O_CONVQ_S = 19509248, O_DELTA_S = 19804160;

struct Params {
    const float *x_prompt, *x_sample, *cache_conv_a, *cache_conv_qkv, *state_delta, *c_prompt, *c_sample,
        *ada_w, *ada_b, *norm1_g, *norm2_g, *w_in, *conv_a_w, *conv_qkv_w, *a_log, *dt_bias, *out_norm_g,
        *w_a_out, *w_b_out, *w_o, *w_ff1, *w_ff2, *final_ada_w, *final_ada_b, *final_norm_g;
    float* out; unsigned char* ws;
};
typedef const __attribute__((address_space(4))) Params* KP;
__device__ __forceinline__ KP kp_get() { KP k = (KP)__builtin_amdgcn_kernarg_segment_ptr(); asm volatile("" : "+s"(k)); return k; }

typedef float f32x2_t __attribute__((ext_vector_type(2)));
typedef __bf16 bf16x2_t __attribute__((ext_vector_type(2)));
__device__ __forceinline__ unsigned pk2(float lo, float hi) { f32x2_t v = {lo, hi}; bf16x2_t b = __builtin_convertvector(v, bf16x2_t); return __builtin_bit_cast(unsigned, b); }
__device__ __forceinline__ unsigned f2bf(float f) { return pk2(f, 0.f) & 0xffffu; }
__device__ __forceinline__ float bflo(unsigned w) { return __builtin_bit_cast(float, w << 16); }
__device__ __forceinline__ float bfhi(unsigned w) { return __builtin_bit_cast(float, w & 0xffff0000u); }
__device__ __forceinline__ float bf2f(bf16 v) { return __builtin_bit_cast(float, ((unsigned)v) << 16); }
__device__ __forceinline__ float sigmoidf_(float x) { return __builtin_amdgcn_rcpf(1.f + __expf(-x)); }
__device__ __forceinline__ float siluf_(float x) { return x * __builtin_amdgcn_rcpf(1.f + __expf(-x)); }
template <int CTRL> __device__ __forceinline__ float dpp_mov(float v) { return __builtin_bit_cast(float, __builtin_amdgcn_update_dpp(0, __builtin_bit_cast(int, v), CTRL, 0xF, 0xF, true)); }
__device__ __forceinline__ float row16_sum(float v) {
    v += dpp_mov<0xB1>(v);
    v += dpp_mov<0x4E>(v);
    v += dpp_mov<0x141>(v);
    v += dpp_mov<0x140>(v);
    return v;
}
__device__ __forceinline__ float wave_sum(float v) {
    v = row16_sum(v);
    const int vi = __builtin_bit_cast(int, v);
    const float r0 = __builtin_bit_cast(float, __builtin_amdgcn_readlane(vi, 0)), r1 = __builtin_bit_cast(float, __builtin_amdgcn_readlane(vi, 16));
    const float r2 = __builtin_bit_cast(float, __builtin_amdgcn_readlane(vi, 32)), r3 = __builtin_bit_cast(float, __builtin_amdgcn_readlane(vi, 48));
    return (r0 + r1) + (r2 + r3);
}
__device__ __forceinline__ int batch_of(int r) { return r < MPROMPT ? (r >> 12) : 4 + ((r - MPROMPT) >> 6); }
#define LDS_WAIT() asm volatile("s_waitcnt lgkmcnt(0)" ::: "memory")

#define XB_TMO      128
#define XB_XCNT(j)  (256  + 64 * (j))
#define XB_XSUB(j)  (1280 + 64 * (j))
#define XB_XGEN(j)  (2304 + 64 * (j))
#define XB_TOP      3328
#define XB_TOPGEN   3392
#define XCD_BAR_WORDS 3456
#define XB_SPIN_CAP (1u << 18)

__device__ __forceinline__ unsigned xb_ld(unsigned* p)              { return __hip_atomic_load(p, __ATOMIC_RELAXED, __HIP_MEMORY_SCOPE_AGENT); }
__device__ __forceinline__ unsigned xb_add(unsigned* p, unsigned v) { return __hip_atomic_fetch_add(p, v, __ATOMIC_RELAXED, __HIP_MEMORY_SCOPE_AGENT); }
__device__ __forceinline__ unsigned xb_xcc_id() { return (unsigned)__builtin_amdgcn_s_getreg((3 << 11) | 20) & 0xFu; }
#define XB_SPIN(cond, bar) do { unsigned _sp = 0; while (cond) { __builtin_amdgcn_s_sleep(1); \
    if ((++_sp & 255u) == 0u) { if (xb_ld(&(bar)[XB_TMO])) break; if (_sp > XB_SPIN_CAP) { atomicAdd(&(bar)[XB_TMO], 1u); break; } } } } while (0)

struct XcdBarrier {
    unsigned* bar; unsigned x;
    volatile LAS unsigned* st;
};

__device__ __forceinline__ XcdBarrier xcd_barrier_post(unsigned* bar, volatile LAS unsigned* st) {
    XcdBarrier b; b.bar = bar; b.x = xb_xcc_id(); b.st = st;
    if (threadIdx.x == 0) (void)xb_add(&bar[XB_XCNT(b.x)], 1u);
    return b;
}
__device__ __forceinline__ void xcd_barrier_complete(unsigned* bar, unsigned x, unsigned& nloc, unsigned& nx) {
    const unsigned G = gridDim.x * gridDim.y * gridDim.z;
    unsigned sum, cnt, mine, sp = 0u;
    for (;;) {
        sum = 0u; cnt = 0u; mine = 0u;
#pragma unroll
        for (unsigned j = 0; j < 16; ++j) { const unsigned c = xb_ld(&bar[XB_XCNT(j)]); sum += c; cnt += (c > 0u) ? 1u : 0u; mine = (j == x) ? c : mine; }
        if (sum == G) break;
        __builtin_amdgcn_s_sleep(1);
        if ((++sp & 255u) == 0u) { if (xb_ld(&bar[XB_TMO])) break; if (sp > XB_SPIN_CAP) { atomicAdd(&bar[XB_TMO], 1u); break; } }
    }
    nloc = mine > 0u ? mine : 1u; nx = cnt > 0u ? cnt : 1u;
}

__device__ __forceinline__ void xcd_barrier(const XcdBarrier& b) {
    asm volatile("s_waitcnt vmcnt(0)" ::: "memory");
    __syncthreads();
    if (threadIdx.x == 0) {
        unsigned* bar = b.bar;
        __builtin_amdgcn_s_waitcnt(0);
        unsigned nloc = b.st[0], nx = b.st[1];
        if (nloc == 0u) { xcd_barrier_complete(bar, b.x, nloc, nx); b.st[0] = nloc; b.st[1] = nx; }
        const unsigned old = xb_add(&bar[XB_XSUB(b.x)], 1u);
        const unsigned gen = old / nloc;
        if (old + 1u == (gen + 1u) * nloc) {
            __builtin_amdgcn_fence(__ATOMIC_RELEASE, "agent");
            asm volatile("s_waitcnt vmcnt(0)" ::: "memory");
            const unsigned og = xb_add(&bar[XB_TOP], 1u);
            const unsigned tg = og / nx;
            if (og + 1u == (tg + 1u) * nx) xb_add(&bar[XB_TOPGEN], 1u);
            else XB_SPIN(xb_ld(&bar[XB_TOPGEN]) == tg, bar);
            __builtin_amdgcn_fence(__ATOMIC_ACQUIRE, "agent");
            xb_add(&bar[XB_XGEN(b.x)], 1u);
            asm volatile("s_waitcnt vmcnt(0)" ::: "memory");
        } else {
            XB_SPIN(xb_ld(&bar[XB_XGEN(b.x)]) == gen, bar);
            __builtin_amdgcn_fence(__ATOMIC_ACQUIRE, "agent");
            asm volatile("s_waitcnt vmcnt(0)" ::: "memory");
        }
    }
    __syncthreads();
}


namespace pg8 {
constexpr int BM = 256, BK = 64, HALF = 128, HTB = HALF * BK * 2, STAGE_BYTES = 8 * HTB, NXCD = 8, WGM = 4;
__host__ __device__ __forceinline__ int lds_byte(int r, int c) { const int st = (r >> 4) * 2 + (c >> 5), rr = r & 15, cc = c & 31, ob = rr * 64 + cc * 2; return st * 1024 + (ob ^ (((ob >> 9) & 1) << 5)); }
__host__ __device__ __forceinline__ void stage_rc(int b, int& R, int& C) { const int st = b / 1024, sb = b % 1024, swz = sb ^ (((sb >> 9) & 1) << 5); R = (st >> 1) * 16 + swz / 64; C = (st & 1) * 32 + (swz % 64) / 2; }
__host__ __device__ __forceinline__ int perm32(int rho) { const int n = rho >> 4, i = rho & 15; return 8 * (i >> 2) + 4 * n + (i & 3); }

struct Unit { int pm, pn, kind, aux; const char* A; const char* Bt; };

__device__ __forceinline__ void decode_tile(int L, int nM, int nN, int& pm, int& pn) {
    const int nwg = nM * nN; int wgid = L;
    { const int q = nwg / NXCD, r = nwg % NXCD, xcd = wgid % NXCD, off = wgid / NXCD; wgid = (xcd < r ? xcd * (q + 1) : r * (q + 1) + (xcd - r) * q) + off; }
    const int nig = WGM * nN, gid = wgid / nig, fm = gid * WGM, gsz = (nM - fm) < WGM ? (nM - fm) : WGM;
    pm = fm + ((wgid % nig) % gsz); pn = (wgid % nig) / gsz;
}

template <class Sched, class Epi>
__device__ __forceinline__ void gemm_phase(LAS unsigned char* lds, const int K, const int ldk, const Sched& S, const Epi& E) {
    int tid = threadIdx.x; asm volatile("" : "+v"(tid));
    const int wid = __builtin_amdgcn_readfirstlane(tid >> 6), lane = tid & 63, wr = wid >> 2, wc = wid & 3, fr = lane & 15, fq = lane >> 4;
    const int nt = K / BK;
    unsigned voffA[2], voffB[2];
#pragma unroll
    for (int i = 0; i < 2; ++i) { int R, C; stage_rc(tid * 16 + i * 8192, R, C); const int Rb = (R & ~31) + perm32(R & 31);
        voffA[i] = (unsigned)(R * ldk + C) * 2u; voffB[i] = (unsigned)(Rb * ldk + C) * 2u; }
    const size_t kstep = (size_t)(BK * 2);
    const size_t hstep = (size_t)HALF * ldk * 2;
    const unsigned ldsw = (unsigned)wid * 1024u;
    const int aoff = lds_byte(wr * 64 + fr, fq * 8), boff = lds_byte(wc * 32 + fr, fq * 8);
#define PG8_SA(b, h) (((b) * 2 + (h)) * HTB)
#define PG8_SB(b, h) ((4 + (b) * 2 + (h)) * HTB)
#define PG8_STAGE(bufoff, gbase, voff) do { _Pragma("unroll") for (int _i = 0; _i < 2; ++_i) \
        __builtin_amdgcn_global_load_lds((const unsigned*)((const char*)(gbase) + (voff)[_i]), (LAS unsigned*)(lds + (bufoff) + ldsw + _i * 8192), 16, 0, 0); } while (0)
#define PG8_LDA(dst, b, h) do { _Pragma("unroll") for (int m = 0; m < 4; ++m) _Pragma("unroll") for (int k = 0; k < 2; ++k) dst[m][k] = *(const LAS bf16x8*)(lds + PG8_SA(b, h) + aoff + m * 2048 + k * 1024); } while (0)
#define PG8_LDB(dst, b, h) do { _Pragma("unroll") for (int n = 0; n < 2; ++n) _Pragma("unroll") for (int k = 0; k < 2; ++k) dst[n][k] = *(const LAS bf16x8*)(lds + PG8_SB(b, h) + boff + n * 2048 + k * 1024); } while (0)
#define PG8_MMA(ai, bj, At, Bt) do { __builtin_amdgcn_s_setprio(1); _Pragma("unroll") for (int m = 0; m < 4; ++m) _Pragma("unroll") for (int n = 0; n < 2; ++n) _Pragma("unroll") for (int k = 0; k < 2; ++k) \
        acc[ai][bj][m][n] = __builtin_amdgcn_mfma_f32_16x16x32_bf16(Bt[n][k], At[m][k], acc[ai][bj][m][n], 0, 0, 0); __builtin_amdgcn_s_setprio(0); } while (0)
#define PG8_WAIT_V(n) asm volatile("s_waitcnt vmcnt(" #n ")" ::: "memory")
#define PG8_WAIT_L(n) asm volatile("s_waitcnt lgkmcnt(" #n ")" ::: "memory")
#define PG8_BAR __builtin_amdgcn_s_barrier()
#define PG8_SCHED __builtin_amdgcn_sched_barrier(0)
    Unit cur, nxt; int ui = 0;
    if (!S.next(0, cur)) return;
    f32x4 acc[2][2][4][2];
#pragma unroll
    for (int a = 0; a < 2; ++a)
#pragma unroll
        for (int b = 0; b < 2; ++b)
#pragma unroll
            for (int m = 0; m < 4; ++m)
#pragma unroll
                for (int n = 0; n < 2; ++n) acc[a][b][m][n] = (f32x4){0.f, 0.f, 0.f, 0.f};
    bf16x8 At[4][2], B0[2][2], B1[2][2];
    const char* cA = cur.A; const char* cB = cur.Bt;
    PG8_STAGE(PG8_SB(0, 0), cB, voffB); PG8_STAGE(PG8_SB(0, 1), cB + hstep, voffB); PG8_STAGE(PG8_SA(0, 0), cA, voffA); PG8_STAGE(PG8_SA(0, 1), cA + hstep, voffA);
    if (wr == 1) PG8_BAR;
    PG8_WAIT_V(2); PG8_BAR;
    PG8_STAGE(PG8_SB(1, 0), cB + kstep, voffB); PG8_STAGE(PG8_SA(1, 0), cA + kstep, voffA); PG8_STAGE(PG8_SB(1, 1), cB + hstep + kstep, voffB);
    PG8_WAIT_V(6); PG8_BAR;
    for (;;) {
        const bool has_next = S.next(ui + 1, nxt);
        const char* nA = has_next ? nxt.A : cA; const char* nB = has_next ? nxt.Bt : cB;
        for (int t = 0; t < nt; t += 2) {
            const bool last = (t == nt - 2);
            const char* a1 = cA + (size_t)(t + 1) * kstep;
            const char* a2 = last ? nA : cA + (size_t)(t + 2) * kstep; const char* b2 = last ? nB : cB + (size_t)(t + 2) * kstep;
            const char* a3 = a2 + kstep; const char* b3 = b2 + kstep;
            PG8_LDB(B0, 0, 0); PG8_LDB(B1, 0, 1); PG8_SCHED; PG8_LDA(At, 0, 0); PG8_STAGE(PG8_SA(1, 1), a1 + hstep, voffA);
            PG8_WAIT_V(8); PG8_WAIT_L(0); PG8_BAR; PG8_MMA(0, 0, At, B0); PG8_MMA(0, 1, At, B1); PG8_BAR; PG8_SCHED;
            PG8_LDA(At, 0, 1); PG8_STAGE(PG8_SB(0, 0), b2, voffB); PG8_STAGE(PG8_SB(0, 1), b2 + hstep, voffB); PG8_STAGE(PG8_SA(0, 0), a2, voffA);
            PG8_WAIT_V(8); PG8_WAIT_L(0); PG8_BAR; PG8_MMA(1, 0, At, B0); PG8_MMA(1, 1, At, B1); PG8_BAR; PG8_SCHED;
            PG8_LDB(B0, 1, 0); PG8_LDB(B1, 1, 1); PG8_SCHED; PG8_LDA(At, 1, 0); PG8_STAGE(PG8_SA(0, 1), a2 + hstep, voffA);
            PG8_WAIT_V(8); PG8_WAIT_L(0); PG8_BAR; PG8_MMA(0, 0, At, B0); PG8_MMA(0, 1, At, B1); PG8_BAR; PG8_SCHED;
            PG8_LDA(At, 1, 1); PG8_STAGE(PG8_SB(1, 0), b3, voffB); PG8_STAGE(PG8_SB(1, 1), b3 + hstep, voffB); PG8_STAGE(PG8_SA(1, 0), a3, voffA);
            PG8_WAIT_V(8); PG8_WAIT_L(0); PG8_BAR; PG8_MMA(1, 0, At, B0); PG8_MMA(1, 1, At, B1); PG8_BAR; PG8_SCHED;
        }
        if (wr == 0) PG8_BAR;
        E(acc, cur, wr, wc, fr, fq);
        if (!has_next) break;
#pragma unroll
        for (int a = 0; a < 2; ++a)
#pragma unroll
            for (int b = 0; b < 2; ++b)
#pragma unroll
                for (int m = 0; m < 4; ++m)
#pragma unroll
                    for (int n = 0; n < 2; ++n) acc[a][b][m][n] = (f32x4){0.f, 0.f, 0.f, 0.f};
        cur = nxt; cA = nA; cB = nB; ++ui;
        if (wr == 1) PG8_BAR;
    }
    PG8_WAIT_V(0);
    PG8_BAR;
#undef PG8_SA
#undef PG8_SB
#undef PG8_STAGE
#undef PG8_LDA
#undef PG8_LDB
#undef PG8_MMA
#undef PG8_WAIT_V
#undef PG8_WAIT_L
#undef PG8_BAR
#undef PG8_SCHED
}
}

enum { K_PA = 0, K_PQ, K_AB, K_Z, K_YA, K_GA, K_YB, K_GB, K_O, K_FF1, K_FF2, K_OS, K_FF2S, K_SGT, K_YBS };

struct Epi {
    __device__ __forceinline__ void operator()(const f32x4 (&acc)[2][2][4][2], const pg8::Unit& u, int wr, int wc, int fr, int fq) const {
        const KP P = kp_get();
        unsigned char* ws = P->ws;
        const int kind = u.kind;
        const int rbase = u.pm * 256 + wr * 64 + fr, cbase = u.pn * 256 + wc * 32 + 8 * fq;
#define EPI_PACK(w, v0, v1) do { w.x = pk2(v0[0], v0[1]); w.y = pk2(v0[2], v0[3]); w.z = pk2(v1[0], v1[1]); w.w = pk2(v1[2], v1[3]); } while (0)
        if (kind == K_PA && u.pn >= 4) {
            bf16* base = (bf16*)(ws + WS_R1) + 1024 + 128 * (u.pn - 4) + wc * 32 + 8 * fq;
#pragma unroll
            for (int ai = 0; ai < 2; ++ai)
#pragma unroll
                for (int m = 0; m < 4; ++m) {
                    const f32x4 v0 = acc[ai][0][m][0] * acc[ai][1][m][0], v1 = acc[ai][0][m][1] * acc[ai][1][m][1];
                    u32x4 w; EPI_PACK(w, v0, v1);
                    *(u32x4*)(base + (size_t)(rbase + ai * 128 + m * 16) * 3072) = w;
                }
        } else if (kind == K_PA || kind == K_PQ || kind == K_FF1 || kind == K_Z || kind == K_YA || kind == K_YB) {
            bf16* base; int ld;
            if (kind == K_PA || kind == K_PQ) { base = (bf16*)(ws + WS_R1); ld = 3072; }
            else if (kind == K_FF1) { base = (bf16*)(ws + WS_R1); ld = FF; }
            else if (kind == K_YA) { base = (bf16*)(ws + WS_R3); ld = D; }
            else { base = (bf16*)P->out; ld = D; }
#pragma unroll
            for (int ai = 0; ai < 2; ++ai)
#pragma unroll
                for (int m = 0; m < 4; ++m) {
                    const int r = rbase + ai * 128 + m * 16;
#pragma unroll
                    for (int bj = 0; bj < 2; ++bj) {
                        const int c0 = cbase + bj * 128;
                        f32x4 v0 = acc[ai][bj][m][0], v1 = acc[ai][bj][m][1];
                        if (kind == K_FF1) {
#pragma unroll
                            for (int e = 0; e < 4; ++e) { float x = fmaxf(v0[e], 0.f), y = fmaxf(v1[e], 0.f); v0[e] = x * x; v1[e] = y * y; }
                        } else if (kind == K_Z) {
#pragma unroll
                            for (int e = 0; e < 4; ++e) { v0[e] = siluf_(v0[e]); v1[e] = siluf_(v1[e]); }
                        }
                        u32x4 w; EPI_PACK(w, v0, v1);
                        *(u32x4*)(base + (size_t)r * ld + c0) = w;
                        if (kind == K_PQ && (r & 63) >= 61) *(u32x4*)((bf16*)(ws + WS_HALO) + ((size_t)(r >> 6) * 3 + ((r & 63) - 61)) * 3072 + c0) = w;
                    }
                }
        } else if (kind == K_AB) {
            if (wc == 0 && fq < 2) {
                float ea[8], db[8];
#pragma unroll
                for (int e = 0; e < 8; ++e) { ea[e] = -__expf(P->a_log[e]); db[e] = P->dt_bias[e]; }
#pragma unroll
                for (int ai = 0; ai < 2; ++ai)
#pragma unroll
                    for (int m = 0; m < 4; ++m) {
                        const int r = rbase + ai * 128 + m * 16;
                        const f32x4 v0 = acc[ai][0][m][0], v1 = acc[ai][0][m][1];
                        f32x4 o0, o1;
                        if (fq == 0) {
#pragma unroll
                            for (int e = 0; e < 4; ++e) {
                                const float a0 = v0[e] + db[e], a1 = v1[e] + db[4 + e];
                                const float s0 = a0 > 20.f ? a0 : __logf(1.f + __expf(a0)), s1 = a1 > 20.f ? a1 : __logf(1.f + __expf(a1));
                                o0[e] = ea[e] * s0; o1[e] = ea[4 + e] * s1;
                            }
                            float* g = (float*)(ws + WS_G) + (size_t)r * 8; *(f32x4*)g = o0; *(f32x4*)(g + 4) = o1;
                        } else {
#pragma unroll
                            for (int e = 0; e < 4; ++e) { o0[e] = sigmoidf_(v0[e]); o1[e] = sigmoidf_(v1[e]); }
                            float* g = (float*)(ws + WS_BETA) + (size_t)r * 8; *(f32x4*)g = o0; *(f32x4*)(g + 4) = o1;
                        }
                    }
            }
        } else if (kind == K_GA || kind == K_GB) {
            bf16* ym = (bf16*)(ws + WS_R3); const bf16* yb = (const bf16*)P->out;
#pragma unroll
            for (int am = 0; am < 4; ++am) {
                const int ai = am >> 1, mh = (am & 1) * 2;
                u32x4 a[2][2], b[2][2];
#pragma unroll
                for (int m = 0; m < 2; ++m)
#pragma unroll
                    for (int bj = 0; bj < 2; ++bj) {
                        const size_t o = (size_t)(rbase + ai * 128 + (mh + m) * 16) * D + cbase + bj * 128;
                        a[m][bj] = *(const u32x4*)(ym + o);
                        if (kind == K_GB) b[m][bj] = *(const u32x4*)(yb + o); else b[m][bj] = (u32x4){0u, 0u, 0u, 0u};
                    }
#pragma unroll
                for (int m = 0; m < 2; ++m)
#pragma unroll
                    for (int bj = 0; bj < 2; ++bj) {
                        const size_t o = (size_t)(rbase + ai * 128 + (mh + m) * 16) * D + cbase + bj * 128;
                        const f32x4 v0 = acc[ai][bj][mh + m][0], v1 = acc[ai][bj][mh + m][1];
                        const u32x4 ya = a[m][bj], y2 = b[m][bj]; u32x4 w;
                        if (kind == K_GA) {
                            w.x = pk2(sigmoidf_(v0[0]) * bflo(ya.x), sigmoidf_(v0[1]) * bfhi(ya.x)); w.y = pk2(sigmoidf_(v0[2]) * bflo(ya.y), sigmoidf_(v0[3]) * bfhi(ya.y));
                            w.z = pk2(sigmoidf_(v1[0]) * bflo(ya.z), sigmoidf_(v1[1]) * bfhi(ya.z)); w.w = pk2(sigmoidf_(v1[2]) * bflo(ya.w), sigmoidf_(v1[3]) * bfhi(ya.w));
                        } else {
                            w.x = pk2(bflo(ya.x) + sigmoidf_(v0[0]) * bflo(y2.x), bfhi(ya.x) + sigmoidf_(v0[1]) * bfhi(y2.x));
                            w.y = pk2(bflo(ya.y) + sigmoidf_(v0[2]) * bflo(y2.y), bfhi(ya.y) + sigmoidf_(v0[3]) * bfhi(y2.y));
                            w.z = pk2(bflo(ya.z) + sigmoidf_(v1[0]) * bflo(y2.z), bfhi(ya.z) + sigmoidf_(v1[1]) * bfhi(y2.z));
                            w.w = pk2(bflo(ya.w) + sigmoidf_(v1[2]) * bflo(y2.w), bfhi(ya.w) + sigmoidf_(v1[3]) * bfhi(y2.w));
                        }
                        *(u32x4*)(ym + o) = w;
                    }
            }
        } else if (kind == K_SGT) {
            bf16* sg = (bf16*)(ws + WS_HALO) - (size_t)MPROMPT * D;
#pragma unroll
            for (int ai = 0; ai < 2; ++ai)
#pragma unroll
                for (int m = 0; m < 4; ++m)
#pragma unroll
                    for (int bj = 0; bj < 2; ++bj) {
                        f32x4 v0 = acc[ai][bj][m][0], v1 = acc[ai][bj][m][1];
#pragma unroll
                        for (int e = 0; e < 4; ++e) { v0[e] = sigmoidf_(v0[e]); v1[e] = sigmoidf_(v1[e]); }
                        u32x4 w; EPI_PACK(w, v0, v1);
                        *(u32x4*)(sg + (size_t)(rbase + ai * 128 + m * 16) * D + cbase + bj * 128) = w;
                    }
        } else if (kind == K_YBS) {
            const bf16* sg = (const bf16*)(ws + WS_HALO) - (size_t)MPROMPT * D;
            bf16* part = (bf16*)(ws + WS_R1) + ((size_t)u.aux * 2048 - MPROMPT) * D;
#pragma unroll
            for (int ai = 0; ai < 2; ++ai) {
                u32x4 g[4][2];
#pragma unroll
                for (int m = 0; m < 4; ++m)
#pragma unroll
                    for (int bj = 0; bj < 2; ++bj) g[m][bj] = *(const u32x4*)(sg + (size_t)(rbase + ai * 128 + m * 16) * D + cbase + bj * 128);
#pragma unroll
                for (int m = 0; m < 4; ++m)
#pragma unroll
                    for (int bj = 0; bj < 2; ++bj) {
                        const f32x4 a0 = acc[ai][bj][m][0], a1 = acc[ai][bj][m][1]; const u32x4 gg = g[m][bj];
                        u32x4 w; w.x = pk2(bflo(gg.x) * a0[0], bfhi(gg.x) * a0[1]); w.y = pk2(bflo(gg.y) * a0[2], bfhi(gg.y) * a0[3]);
                        w.z = pk2(bflo(gg.z) * a1[0], bfhi(gg.z) * a1[1]); w.w = pk2(bflo(gg.w) * a1[2], bfhi(gg.w) * a1[3]);
                        *(u32x4*)(part + (size_t)(rbase + ai * 128 + m * 16) * D + cbase + bj * 128) = w;
                    }
            }
        } else if (kind == K_OS || kind == K_FF2S) {
            const float* modp = (const float*)(ws + WS_MOD);
            bf16* part = (bf16*)(ws + (kind == K_OS ? WS_R1 : WS_XN)) + ((size_t)u.aux * 2048 - MPROMPT) * D;
#pragma unroll
            for (int ai = 0; ai < 2; ++ai) {
                const int r0 = rbase + ai * 128;
                const float* gt = modp + (size_t)batch_of(r0) * 6144 + (kind == K_OS ? 2048 : 5120) + cbase;
#pragma unroll
                for (int bj = 0; bj < 2; ++bj) {
                    const f32x4 g0 = *(const f32x4*)(gt + bj * 128), g1 = *(const f32x4*)(gt + bj * 128 + 4);
#pragma unroll
                    for (int m = 0; m < 4; ++m) {
                        const f32x4 v0 = g0 * acc[ai][bj][m][0], v1 = g1 * acc[ai][bj][m][1];
                        u32x4 w; EPI_PACK(w, v0, v1);
                        *(u32x4*)(part + (size_t)(r0 + m * 16) * D + cbase + bj * 128) = w;
                    }
                }
            }
        } else {
            const float* modp = (const float*)(ws + WS_MOD);
#pragma unroll
            for (int am = 0; am < 4; ++am) {
                const int ai = am >> 1, mh = (am & 1) * 2;
                const int r0 = rbase + ai * 128 + mh * 16;
                const float* gt = modp + (size_t)batch_of(r0) * 6144 + (kind == K_O ? 2048 : 5120) + cbase;
                f32x4 g[2][2], x[2][2][2];
#pragma unroll
                for (int bj = 0; bj < 2; ++bj) { g[bj][0] = *(const f32x4*)(gt + bj * 128); g[bj][1] = *(const f32x4*)(gt + bj * 128 + 4); }
#pragma unroll
                for (int m = 0; m < 2; ++m) {
                    const int r = r0 + m * 16;
                    const float* xr = (kind == K_O) ? ((r < MPROMPT ? P->x_prompt + (size_t)r * D : P->x_sample + (size_t)(r - MPROMPT) * D) + cbase) : (P->out + (size_t)r * D + cbase);
#pragma unroll
                    for (int bj = 0; bj < 2; ++bj) { x[m][bj][0] = *(const f32x4*)(xr + bj * 128); x[m][bj][1] = *(const f32x4*)(xr + bj * 128 + 4); }
                }
#pragma unroll
                for (int m = 0; m < 2; ++m) {
                    float* dst = P->out + (size_t)(r0 + m * 16) * D + cbase;
#pragma unroll
                    for (int bj = 0; bj < 2; ++bj) {
                        *(f32x4*)(dst + bj * 128) = x[m][bj][0] + g[bj][0] * acc[ai][bj][mh + m][0];
                        *(f32x4*)(dst + bj * 128 + 4) = x[m][bj][1] + g[bj][1] * acc[ai][bj][mh + m][1];
                    }
                }
            }
        }
#undef EPI_PACK
    }
};

struct SchedFlat {
    const bf16 *A0, *A1, *A2; const bf16 *B0, *B1, *B2; int n0, n1, n2, k0, k1, k2; int nN, G, c, K;
    __device__ __forceinline__ bool next(int i, pg8::Unit& u) const {
        const long L = (long)i * G + c; if (L >= (long)72 * nN) return false;
        int pm, pg; pg8::decode_tile((int)L, 72, nN, pm, pg);
        const bf16* A; const bf16* B; int kind, pn;
        if (pg < n0) { A = A0; B = B0; kind = k0; pn = pg; }
        else if (pg < n0 + n1) { A = A1; B = B1; kind = k1; pn = pg - n0; }
        else { A = A2; B = B2; kind = k2; pn = pg - n0 - n1; }
        u.pm = pm; u.pn = pn; u.kind = kind; u.aux = 0;
        u.A = (const char*)A + (size_t)pm * 256 * K * 2; u.Bt = (const char*)B + (size_t)pn * 256 * K * 2;
        return true;
    }
};
struct SchedPair {
    const bf16 *A0, *A1; const bf16 *B0, *B1; int k0, k1; int G, c, K;
    __device__ __forceinline__ bool next(int i, pg8::Unit& u) const {
        const int j = i >> 1, half = i & 1; const long L = (long)j * G + c; if (L >= 288) return false;
        int pm, pn; pg8::decode_tile((int)L, 72, 4, pm, pn);
        u.pm = pm; u.pn = pn; u.kind = half ? k1 : k0; u.aux = 0;
        u.A = (const char*)(half ? A1 : A0) + (size_t)pm * 256 * K * 2; u.Bt = (const char*)(half ? B1 : B0) + (size_t)pn * 256 * K * 2;
        return true;
    }
};

struct SchedP2 {
    const bf16 *XNp, *Bp, *Bz; int c;
    __device__ __forceinline__ bool next(int i, pg8::Unit& u) const {
        const int L = i * 256 + c; if (L >= 1024) return false;
        int pm, pn; const bf16* B;
        if (L < 864) { pg8::decode_tile(L, 72, 12, pm, pn); u.kind = K_PA; B = Bp; } else { pg8::decode_tile(L - 864, 72, 4, pm, pn); u.kind = K_Z; B = Bz; }
        u.pm = pm; u.pn = pn; u.aux = 0;
        u.A = (const char*)XNp + (size_t)pm * 256 * D * 2; u.Bt = (const char*)B + (size_t)pn * 256 * D * 2;
        return true;
    }
};
struct SchedP4 {
    const bf16 *XNp, *Bqkv, *Bab, *YAp, *Bya; int c;
    __device__ __forceinline__ bool next(int i, pg8::Unit& u) const {
        const int L = i * 256 + c; if (L >= 1224) return false;
        u.aux = 0;
        if (L < 936) {
            int pm, pg; pg8::decode_tile(L, 72, 13, pm, pg);
            u.pm = pm; u.A = (const char*)XNp + (size_t)pm * 256 * D * 2;
            if (pg < 12) { u.pn = pg; u.kind = K_PQ; u.Bt = (const char*)Bqkv + (size_t)pg * 256 * D * 2; } else { u.pn = 0; u.kind = K_AB; u.Bt = (const char*)Bab; }
        } else {
            int pm, pn; pg8::decode_tile(L - 936, 72, 4, pm, pn);
            u.pm = pm; u.pn = pn; u.kind = K_YA;
            u.A = (const char*)YAp + (size_t)pm * 256 * D * 2; u.Bt = (const char*)Bya + (size_t)pn * 256 * D * 2;
        }
        return true;
    }
};
struct SchedScanG {
    const bf16 *XNp, *Bz, *Bgb, *Bga; int c;
    __device__ __forceinline__ bool next(int i, pg8::Unit& u) const {
        const int L = i * 128 + c; if (L >= 448) return false;
        int pm, pn; const bf16* B;
        if (L < 128) { pg8::decode_tile(160 + L, 72, 4, pm, pn); u.kind = K_Z; B = Bz; }
        else if (L < 160) { const int t = L - 128; pm = 64 + (t >> 2); pn = t & 3; u.kind = K_SGT; B = Bgb; }
        else { pg8::decode_tile(L - 160, 72, 4, pm, pn); u.kind = K_GA; B = Bga; }
        u.pm = pm; u.pn = pn; u.aux = 0;
        u.A = (const char*)XNp + (size_t)pm * 256 * D * 2; u.Bt = (const char*)B + (size_t)pn * 256 * D * 2;
        return true;
    }
};
struct SchedPair64 {
    const bf16 *A0, *A1; const bf16 *B0, *B1; int k0, k1; int G, c;
    __device__ __forceinline__ bool next(int i, pg8::Unit& u) const {
        const int j = i >> 1, half = i & 1; const long L = (long)j * G + c; if (L >= 256) return false;
        int pm, pn; pg8::decode_tile((int)L, 64, 4, pm, pn);
        u.pm = pm; u.pn = pn; u.kind = half ? k1 : k0; u.aux = 0;
        u.A = (const char*)(half ? A1 : A0) + (size_t)pm * 256 * D * 2; u.Bt = (const char*)(half ? B1 : B0) + (size_t)pn * 256 * D * 2;
        return true;
    }
};
struct SchedFull64 {
    const bf16 *A, *B; int kind, G, c, ld;
    __device__ __forceinline__ bool next(int i, pg8::Unit& u) const {
        const long L = (long)i * G + c; if (L >= 256) return false;
        int pm, pn; pg8::decode_tile((int)L, 64, 4, pm, pn);
        u.pm = pm; u.pn = pn; u.kind = kind; u.aux = 0;
        u.A = (const char*)A + (size_t)pm * 256 * ld * 2; u.Bt = (const char*)B + (size_t)pn * 256 * ld * 2;
        return true;
    }
};
struct SchedSlice {
    const bf16 *A, *B; int kind, G, c, ld, ks;
    __device__ __forceinline__ bool next(int i, pg8::Unit& u) const {
        const long L = (long)i * G + c; if (L >= 256) return false;
        const int tile = (int)L >> 3, sl = (int)L & 7;
        u.pm = 64 + (tile >> 2); u.pn = tile & 3; u.kind = kind; u.aux = sl;
        u.A = (const char*)A + ((size_t)u.pm * 256 * ld + (size_t)sl * ks) * 2; u.Bt = (const char*)B + ((size_t)u.pn * 256 * ld + (size_t)sl * ks) * 2;
        return true;
    }
};

struct TrItem { const float* W; bf16* WT; int ldw, K, src0, dst0, kb, nb, dnb; };
__device__ __forceinline__ void transpose_load(const TrItem& t, f32x4 (&v)[8], int lane) {
    const int kk = lane >> 3, c4 = (lane & 7) * 4;
#pragma unroll
    for (int i = 0; i < 8; ++i) v[i] = *(const f32x4*)(t.W + (size_t)(64 * t.kb + 8 * i + kk) * t.ldw + t.src0 + 32 * t.nb + c4);
}
__device__ __forceinline__ void transpose_finish(const TrItem& t, const f32x4 (&v)[8], LAS float* scr, int lane) {
    const int kk = lane >> 3, c4 = (lane & 7) * 4;
#pragma unroll
    for (int i = 0; i < 8; ++i) { LAS float* d = scr + (8 * i + kk) * 33 + c4; d[0] = v[i].x; d[1] = v[i].y; d[2] = v[i].z; d[3] = v[i].w; }
    LDS_WAIT();
    const int c = lane & 7;
#pragma unroll
    for (int j = 0; j < 4; ++j) { const int n = (lane >> 3) + 8 * j; const LAS float* s = scr + (8 * c) * 33 + n;
        u32x4 o; o.x = pk2(s[0 * 33], s[1 * 33]); o.y = pk2(s[2 * 33], s[3 * 33]); o.z = pk2(s[4 * 33], s[5 * 33]); o.w = pk2(s[6 * 33], s[7 * 33]);
        *(u32x4*)(t.WT + (size_t)(t.dst0 + 32 * t.dnb + n) * t.K + 64 * t.kb + 8 * c) = o; }
    LDS_WAIT();
}
__device__ __forceinline__ TrItem tr_decode0(const KP P, unsigned char* ws, int r) {
    constexpr int I0 = 16 * 224, I1 = 16 * 64, I2 = 16 * 32;
    TrItem t; t.K = D;
    if (r < I0) { t.W = P->w_in; t.ldw = 9232; t.src0 = 0; t.WT = (bf16*)(ws + WS_WIN); t.dst0 = 0; t.kb = r / 224; t.nb = r % 224;
        t.dnb = t.nb; if (t.nb >= 32 && t.nb < 64) t.dnb = 32 + 8 * ((t.nb - 32) >> 2) + ((t.nb - 32) & 3); else if (t.nb >= 64 && t.nb < 96) t.dnb = 32 + 8 * ((t.nb - 64) >> 2) + 4 + ((t.nb - 64) & 3);
        return t; } r -= I0;
    if (r < I1) { t.W = P->w_in; t.ldw = 9232; t.src0 = 7184; t.WT = (bf16*)(ws + WS_WIN); t.dst0 = 7168; t.kb = r / 64; t.nb = r % 64; t.dnb = t.nb; return t; } r -= I1;
    t.ldw = D; t.src0 = 0; t.dst0 = 0;
    if (r < I2) { t.W = P->w_a_out; t.WT = (bf16*)(ws + WS_WA); } else if (r < 2 * I2) { t.W = P->w_b_out; t.WT = (bf16*)(ws + WS_WB); r -= I2; } else { t.W = P->w_o; t.WT = (bf16*)(ws + WS_WO); r -= 2 * I2; }
    t.kb = r / 32; t.nb = r % 32; t.dnb = t.nb; return t;
}
__device__ __forceinline__ TrItem tr_decode1(const KP P, unsigned char* ws, int r) {
    TrItem t; t.src0 = 0; t.dst0 = 0;
    if (r < 2048) { t.W = P->w_ff1; t.ldw = FF; t.K = D; t.WT = (bf16*)(ws + WS_WFF1); t.kb = r / 128; t.nb = r % 128; }
    else { r -= 2048; t.W = P->w_ff2; t.ldw = D; t.K = FF; t.WT = (bf16*)(ws + WS_WFF2); t.kb = r / 32; t.nb = r % 32; }
    t.dnb = t.nb; return t;
}

template <int MODE>
__device__ __forceinline__ void norm_phase(const KP P, unsigned char* ws, int gw, int NGW, int lane) {
    const float* g = MODE == 0 ? P->norm1_g : (MODE == 1 ? P->norm2_g : P->final_norm_g);
    const float* modb = (const float*)(ws + (MODE == 2 ? WS_MODF : WS_MOD));
    const int mstride = MODE == 2 ? 2048 : 6144, sco = MODE == 0 ? 1024 : (MODE == 1 ? 4096 : 1024), sho = MODE == 0 ? 0 : (MODE == 1 ? 3072 : 0);
    const float* xp = P->x_prompt; const float* xs = P->x_sample; float* outp = P->out;
    const bf16* part = (const bf16*)(ws + (MODE == 1 ? WS_R1 : WS_XN));
    bf16* xn = (bf16*)(ws + WS_XN);
#define NORM_BODY(v, r) do { \
        const float* mb = modb + (size_t)batch_of(r) * mstride; \
        f32x4 gg[4], ss[4], hh[4]; \
        _Pragma("unroll") for (int j = 0; j < 4; ++j) { const int c = lane * 4 + 256 * j; gg[j] = *(const f32x4*)(g + c); ss[j] = *(const f32x4*)(mb + sco + c); hh[j] = *(const f32x4*)(mb + sho + c); } \
        float s = 0.f; \
        _Pragma("unroll") for (int j = 0; j < 4; ++j) s += (v[j].x * v[j].x + v[j].y * v[j].y) + (v[j].z * v[j].z + v[j].w * v[j].w); \
        const float rstd = 1.f / sqrtf(wave_sum(s) * (1.f / D) + EPS); \
        _Pragma("unroll") for (int j = 0; j < 4; ++j) { \
            const int c = lane * 4 + 256 * j; \
            const f32x4 o = (v[j] * rstd) * gg[j] * (ss[j] + 1.f) + hh[j]; \
            if (MODE == 2) *(f32x4*)(outp + (size_t)(r) * D + c) = o; \
            else { u32x2 w; w.x = pk2(o.x, o.y); w.y = pk2(o.z, o.w); *(u32x2*)(xn + (size_t)(r) * D + c) = w; } \
        } } while (0)
    const float* src = MODE == 0 ? xp : outp;
    int r = gw; f32x4 nv[2][4];
#pragma unroll
    for (int u = 0; u < 2; ++u) if (r + u * NGW < MPROMPT) {
#pragma unroll
        for (int j = 0; j < 4; ++j) nv[u][j] = *(const f32x4*)(src + (size_t)(r + u * NGW) * D + lane * 4 + 256 * j); }
    for (; r < MPROMPT; r += 2 * NGW) {
        f32x4 v0[4], v1[4];
#pragma unroll
        for (int j = 0; j < 4; ++j) { v0[j] = nv[0][j]; v1[j] = nv[1][j]; }
#pragma unroll
        for (int u = 0; u < 2; ++u) { const int rn = r + (2 + u) * NGW; if (rn < MPROMPT) {
#pragma unroll
            for (int j = 0; j < 4; ++j) nv[u][j] = *(const f32x4*)(src + (size_t)rn * D + lane * 4 + 256 * j); } }
        NORM_BODY(v0, r);
        if (r + NGW < MPROMPT) { const int r1 = r + NGW; NORM_BODY(v1, r1); }
    }
    for (r = MPROMPT + gw; r < MTOK; r += NGW) {
        f32x4 v[4];
        const float* xr = MODE == 2 ? outp + (size_t)r * D : xs + (size_t)(r - MPROMPT) * D;
#pragma unroll
        for (int j = 0; j < 4; ++j) v[j] = *(const f32x4*)(xr + lane * 4 + 256 * j);
        if (MODE != 0) {
            u32x2 pw[8][4];
#pragma unroll
            for (int sl = 0; sl < 8; ++sl)
#pragma unroll
                for (int j = 0; j < 4; ++j) pw[sl][j] = *(const u32x2*)(part + ((size_t)sl * 2048 + (r - MPROMPT)) * D + lane * 4 + 256 * j);
#pragma unroll
            for (int sl = 0; sl < 8; ++sl)
#pragma unroll
                for (int j = 0; j < 4; ++j) { v[j].x += bflo(pw[sl][j].x); v[j].y += bfhi(pw[sl][j].x); v[j].z += bflo(pw[sl][j].y); v[j].w += bfhi(pw[sl][j].y); }
            if (MODE == 1) {
#pragma unroll
                for (int j = 0; j < 4; ++j) *(f32x4*)(outp + (size_t)r * D + lane * 4 + 256 * j) = v[j];
            }
        }
        NORM_BODY(v, r);
    }
#undef NORM_BODY
}

__global__ void __launch_bounds__(512, 2) mega_fwd(Params p) {
    extern __shared__ __attribute__((aligned(16))) unsigned char smem[];
    LAS unsigned char* lds = (LAS unsigned char*)smem;
    cg::grid_group grid = cg::this_grid();
    volatile LAS unsigned* xst = (volatile LAS unsigned*)(lds + LDS_BYTES - 16);
    if (threadIdx.x < 4) xst[threadIdx.x] = 0u;
    __syncthreads();
    const XcdBarrier xbar = xcd_barrier_post((unsigned*)(p.ws + WS_BAR), xst);
    if (gridDim.x == 0x7fffffffu) grid.sync();
#define PHASE_BEGIN const KP P = kp_get(); unsigned char* const ws = P->ws; (void)ws; \
    int tid = threadIdx.x; asm volatile("" : "+v"(tid)); const int lane = tid & 63, wave = __builtin_amdgcn_readfirstlane(tid >> 6); \
    int bid = blockIdx.x; asm volatile("" : "+s"(bid)); const int G = gridDim.x; const int gw = bid * 8 + wave, NGW = G * 8; (void)lane; (void)gw; (void)NGW;
#define mod ((float*)(ws + WS_MOD))
#define modf ((float*)(ws + WS_MODF))
#define XN ((bf16*)(ws + WS_XN))
#define R1 ((bf16*)(ws + WS_R1))
#define R2 ((bf16*)(ws + WS_R2))
#define R3 ((bf16*)(ws + WS_R3))
#define WIN ((bf16*)(ws + WS_WIN))
#define WA ((bf16*)(ws + WS_WA))
#define WB ((bf16*)(ws + WS_WB))
#define WO ((bf16*)(ws + WS_WO))
#define WFF1 ((bf16*)(ws + WS_WFF1))
#define WFF2 ((bf16*)(ws + WS_WFF2))
#define GLOG ((float*)(ws + WS_G))
#define BETA ((float*)(ws + WS_BETA))
#define GC ((float*)(ws + WS_GC))
#define HALO ((bf16*)(ws + WS_HALO))
#define ZB ((bf16*)P->out)
#define OB ((bf16*)((unsigned char*)P->out + 36 * MiB))
    const Epi E{};

    {
        PHASE_BEGIN
        LAS bf16* cs = (LAS bf16*)lds;
        for (int i = tid; i < NB * D / 4; i += 512) { const int r = i >> 8, k = (i & 255) * 4; const f32x4 c = *(const f32x4*)(r < 4 ? P->c_prompt + r * D + k : P->c_sample + (r - 4) * D + k);
            u32x2 w; w.x = pk2(c.x * __builtin_amdgcn_rcpf(1.f + __expf(-c.x)), c.y * __builtin_amdgcn_rcpf(1.f + __expf(-c.y))); w.y = pk2(c.z * __builtin_amdgcn_rcpf(1.f + __expf(-c.z)), c.w * __builtin_amdgcn_rcpf(1.f + __expf(-c.w)));
            *(LAS u32x2*)(cs + r * 1032 + k) = w; }
        __syncthreads();
        LAS float* scr = (LAS float*)(lds + 74304 + wave * 8448);
        {
            const int cg = 2 * bid + (wave >> 2), kq = wave & 3;
            int col0 = cg * 16; const float* W; const float* bias; float* outp; int ld;
            if (col0 < 6144) { W = P->ada_w; bias = P->ada_b; outp = mod; ld = 6144; } else { col0 -= 6144; W = P->final_ada_w; bias = P->final_ada_b; outp = modf; ld = 2048; }
            const int n = lane & 15, q = lane >> 4;
            f32x4 acc[3] = {{0.f, 0.f, 0.f, 0.f}, {0.f, 0.f, 0.f, 0.f}, {0.f, 0.f, 0.f, 0.f}};
            if (cg < 512) {
#pragma unroll 4
                for (int ks = 8 * kq; ks < 8 * kq + 8; ++ks) {
                    const float* wp = W + (size_t)(32 * ks + 8 * q) * ld + col0 + n;
                    float wv[8];
#pragma unroll
                    for (int j = 0; j < 8; ++j) wv[j] = wp[(size_t)j * ld];
                    u32x4 bw; bw.x = pk2(wv[0], wv[1]); bw.y = pk2(wv[2], wv[3]); bw.z = pk2(wv[4], wv[5]); bw.w = pk2(wv[6], wv[7]);
                    const bf16x8 bfrag = __builtin_bit_cast(bf16x8, bw);
#pragma unroll
                    for (int mt = 0; mt < 3; ++mt) {
                        const int row = 16 * mt + n;
                        bf16x8 afrag = {0, 0, 0, 0, 0, 0, 0, 0};
                        if (row < NB) afrag = *(const LAS bf16x8*)(cs + row * 1032 + 32 * ks + 8 * q);
                        acc[mt] = __builtin_amdgcn_mfma_f32_16x16x32_bf16(afrag, bfrag, acc[mt], 0, 0, 0);
                    }
                }
            }
#pragma unroll
            for (int mt = 0; mt < 3; ++mt) *(LAS f32x4*)(scr + (mt * 64 + lane) * 4) = acc[mt];
            __syncthreads();
            if (kq == 0 && cg < 512) {
                const float bv = bias[col0 + n];
#pragma unroll
                for (int mt = 0; mt < 3; ++mt) {
                    f32x4 t = acc[mt];
#pragma unroll
                    for (int w2 = 1; w2 < 4; ++w2) t += *(const LAS f32x4*)((LAS float*)(lds + 74304 + (wave + w2) * 8448) + (mt * 64 + lane) * 4);
#pragma unroll
                    for (int jj = 0; jj < 4; ++jj) { const int row = 16 * mt + 4 * q + jj; if (row < NB) outp[(size_t)row * ld + col0 + n] = t[jj] + bv; }
                }
            }
            __syncthreads();
        }
        constexpr int NT = 16 * 224 + 16 * 64 + 3 * 16 * 32;
        for (int base = gw; base < NT; base += 3 * NGW) {
            TrItem t0 = tr_decode0(P, ws, base), t1 = t0, t2 = t0; f32x4 v0[8], v1[8], v2[8];
            const bool h1 = base + NGW < NT, h2 = base + 2 * NGW < NT;
            transpose_load(t0, v0, lane);
            if (h1) { t1 = tr_decode0(P, ws, base + NGW); transpose_load(t1, v1, lane); }
            if (h2) { t2 = tr_decode0(P, ws, base + 2 * NGW); transpose_load(t2, v2, lane); }
            transpose_finish(t0, v0, scr, lane);
            if (h1) transpose_finish(t1, v1, scr, lane);
            if (h2) transpose_finish(t2, v2, scr, lane);
        }
        if (gw == NGW - 1) {
            for (int e = lane; e < 16 * D; e += 64) { const int n = e >> 10, k = e & 1023; WIN[(size_t)(9216 + n) * D + k] = (bf16)f2bf(P->w_in[(size_t)k * 9232 + 7168 + n]); }
        }
    }
    xcd_barrier(xbar);

    { PHASE_BEGIN
      norm_phase<0>(P, ws, gw, NGW, lane); }
    xcd_barrier(xbar);

    {
        PHASE_BEGIN
        SchedP2 S; S.XNp = XN; S.Bp = WIN; S.Bz = WIN + (size_t)6144 * D; S.c = bid;
        pg8::gemm_phase(lds, D, D, S, E);
    }
    xcd_barrier(xbar);

    { PHASE_BEGIN
    for (int idx = bid * 512 + tid; idx < MTOK * 128; idx += G * 512) {
        const int r = idx >> 7, c8 = (idx & 127) * 8;
        const bool prm = r < MPROMPT; const int tpos = prm ? (r & 4095) : ((r - MPROMPT) & 63); const int T = prm ? 4096 : 64; const int bs = prm ? (r >> 12) : ((r - MPROMPT) >> 6);
        const bf16* row = R1 + (size_t)r * 3072 + c8;
        const u32x4 pb = *(const u32x4*)row, uv0 = *(const u32x4*)(row + 1024);
        float u0[8], u1[8], u2[8];
#define P3_UNPK(U_, W_) do { U_[0] = bflo(W_.x); U_[1] = bfhi(W_.x); U_[2] = bflo(W_.y); U_[3] = bfhi(W_.y); U_[4] = bflo(W_.z); U_[5] = bfhi(W_.z); U_[6] = bflo(W_.w); U_[7] = bfhi(W_.w); } while (0)
        P3_UNPK(u0, uv0);
        if (tpos >= 1) { const u32x4 w1 = *(const u32x4*)(row - 3072 + 1024); P3_UNPK(u1, w1); }
        else {
#pragma unroll
            for (int e = 0; e < 8; ++e) u1[e] = prm ? 0.f : P->cache_conv_a[((size_t)bs * 2 + 1) * D + c8 + e];
        }
        if (tpos >= 2) { const u32x4 w2 = *(const u32x4*)(row - 6144 + 1024); P3_UNPK(u2, w2); }
        else {
#pragma unroll
            for (int e = 0; e < 8; ++e) u2[e] = prm ? 0.f : P->cache_conv_a[((size_t)bs * 2 + tpos) * D + c8 + e];
        }
#undef P3_UNPK
        float y[8];
#pragma unroll
        for (int e = 0; e < 8; ++e) y[e] = P->conv_a_w[c8 + e] * u2[e] + P->conv_a_w[D + c8 + e] * u1[e] + P->conv_a_w[2 * D + c8 + e] * u0[e];
        u32x4 o; o.x = pk2(bflo(pb.x) * y[0], bfhi(pb.x) * y[1]); o.y = pk2(bflo(pb.y) * y[2], bfhi(pb.y) * y[3]);
        o.z = pk2(bflo(pb.z) * y[4], bfhi(pb.z) * y[5]); o.w = pk2(bflo(pb.w) * y[6], bfhi(pb.w) * y[7]);
        *(u32x4*)(R2 + (size_t)r * D + c8) = o;
        if (tpos >= T - 2) {
            float* dst = P->out + (prm ? O_CONVA_P : O_CONVA_S) + ((size_t)bs * 2 + (tpos - (T - 2))) * D + c8;
            *(f32x4*)dst = (f32x4){u0[0], u0[1], u0[2], u0[3]}; *(f32x4*)(dst + 4) = (f32x4){u0[4], u0[5], u0[6], u0[7]};
        }
    } }
    xcd_barrier(xbar);

    {
        PHASE_BEGIN
        SchedP4 S; S.XNp = XN; S.Bqkv = WIN + (size_t)3072 * D; S.Bab = WIN + (size_t)9216 * D; S.YAp = R2; S.Bya = WA; S.c = bid;
        pg8::gemm_phase(lds, D, D, S, E);
    }
    xcd_barrier(xbar);

    { PHASE_BEGIN
    for (int it = gw; it < NCHUNK * 24; it += NGW) {
        const int cidx = it / 24, s = it % 24, part = s >> 3;
        const int col = s * 128 + 2 * lane;
        const bool prm = cidx < 256; const int bs = prm ? (cidx >> 6) : (cidx - 256);
        const bool first = prm ? ((cidx & 63) == 0) : true; const bool lastc = prm ? ((cidx & 63) == 63) : true;
        float xa[3], xb[3];
#pragma unroll
        for (int j = 0; j < 3; ++j) {
            if (!first) { const unsigned w = *(const unsigned*)(HALO + ((size_t)(cidx - 1) * 3 + j) * 3072 + col); xa[j] = bflo(w); xb[j] = bfhi(w); }
            else if (prm) { xa[j] = 0.f; xb[j] = 0.f; }
            else { const float* cp = P->cache_conv_qkv + ((size_t)bs * 3 + j) * 3072 + col; xa[j] = cp[0]; xb[j] = cp[1]; }
        }
        float wa[4], wb[4];
#pragma unroll
        for (int j = 0; j < 4; ++j) { wa[j] = P->conv_qkv_w[(size_t)j * 3072 + col]; wb[j] = P->conv_qkv_w[(size_t)j * 3072 + col + 1]; }
        bf16* base = R1 + (size_t)cidx * 64 * 3072 + col;
        const float qs = part == 0 ? 0.08838834764831845f : 1.f;
#pragma unroll
        for (int hb = 0; hb < 2; ++hb) {
            unsigned xv[32];
#pragma unroll
            for (int t = 0; t < 32; ++t) xv[t] = *(const unsigned*)(base + (size_t)(hb * 32 + t) * 3072);
#pragma unroll
            for (int t = 0; t < 32; ++t) {
                const float x0 = bflo(xv[t]), x1 = bfhi(xv[t]);
                const float y0 = wa[0] * xa[0] + wa[1] * xa[1] + wa[2] * xa[2] + wa[3] * x0;
                const float y1 = wb[0] * xb[0] + wb[1] * xb[1] + wb[2] * xb[2] + wb[3] * x1;
                xa[0] = xa[1]; xa[1] = xa[2]; xa[2] = x0; xb[0] = xb[1]; xb[1] = xb[2]; xb[2] = x1;
                float s0 = y0 * __builtin_amdgcn_rcpf(1.f + __expf(-y0)), s1 = y1 * __builtin_amdgcn_rcpf(1.f + __expf(-y1));
                if (part < 2) { const float ss = wave_sum(s0 * s0 + s1 * s1); const float sc = qs * __builtin_amdgcn_rsqf(ss + EPS); s0 *= sc; s1 *= sc; }
                *(unsigned*)(base + (size_t)(hb * 32 + t) * 3072) = pk2(s0, s1);
            }
        }
        if (lastc) {
            float* dst = P->out + (prm ? O_CONVQ_P : O_CONVQ_S) + (size_t)bs * 3 * 3072 + col;
#pragma unroll
            for (int j = 0; j < 3; ++j) { dst[(size_t)j * 3072] = xa[j]; dst[(size_t)j * 3072 + 1] = xb[j]; }
        }
    } }
    xcd_barrier(xbar);

    {
        PHASE_BEGIN
        LAS float* Am = (LAS float*)(lds + wave * 16896);
        LAS float* gcs = Am + 4096;
        LAS float* bts = gcs + 64;
        bf16* TP = R2; bf16* QKM = R2 + (size_t)NCHUNK * 8 * 4096;
        const int n = lane & 15, q = lane >> 4;
#pragma unroll 1
        for (int rnd = 0; rnd < 2; ++rnd) {
            const int it = rnd == 0 ? gw : (wave == 0 ? 2048 + bid : 1 << 30);
            if (it >= NCHUNK * 8) continue;
            const int cidx = it >> 3, h = it & 7; const int r0 = cidx * 64;
            float gv = GLOG[(size_t)(r0 + lane) * 8 + h]; const float bt = BETA[(size_t)(r0 + lane) * 8 + h];
#pragma unroll
            for (int o = 1; o < 64; o <<= 1) { const float t = __shfl_up(gv, o); if (lane >= o) gv += t; }
            gcs[lane] = gv; bts[lane] = bt; GC[(size_t)it * 64 + lane] = gv;
            LDS_WAIT();
            const bf16* qb = R1 + (size_t)r0 * 3072 + h * 128; const bf16* kb = qb + 1024;
            bf16x8 kf[4][4];
#pragma unroll
            for (int mt = 0; mt < 4; ++mt)
#pragma unroll
                for (int ks = 0; ks < 4; ++ks) kf[mt][ks] = *(const bf16x8*)(kb + (size_t)(16 * mt + n) * 3072 + 32 * ks + 8 * q);
#pragma unroll
            for (int mi = 0; mi < 4; ++mi)
#pragma unroll
                for (int nj = 0; nj < 4; ++nj) {
                    f32x4 c = {0.f, 0.f, 0.f, 0.f};
#pragma unroll
                    for (int ks = 0; ks < 4; ++ks) c = __builtin_amdgcn_mfma_f32_16x16x32_bf16(kf[mi][ks], kf[nj][ks], c, 0, 0, 0);
                    const int j = 16 * nj + n; const float gj = gcs[j];
#pragma unroll
                    for (int jj = 0; jj < 4; ++jj) { const int i = 16 * mi + 4 * q + jj; const float v = (i > j) ? bts[i] * c[jj] * __expf(gcs[i] - gj) : 0.f; Am[i * 64 + j] = v; }
                }
            {
#pragma unroll
                for (int mi = 0; mi < 4; ++mi) {
                    bf16x8 qf[4];
#pragma unroll
                    for (int ks = 0; ks < 4; ++ks) qf[ks] = *(const bf16x8*)(qb + (size_t)(16 * mi + n) * 3072 + 32 * ks + 8 * q);
#pragma unroll
                    for (int nj = 0; nj < 4; ++nj) {
                        f32x4 c = {0.f, 0.f, 0.f, 0.f};
#pragma unroll
                        for (int ks = 0; ks < 4; ++ks) c = __builtin_amdgcn_mfma_f32_16x16x32_bf16(qf[ks], kf[nj][ks], c, 0, 0, 0);
                        const int j = 16 * nj + n; const float gj = gcs[j];
#pragma unroll
                        for (int jj = 0; jj < 4; ++jj) { const int i = 16 * mi + 4 * q + jj; const float v = (i >= j) ? c[jj] * __expf(gcs[i] - gj) : 0.f; QKM[(size_t)it * 4096 + i * 64 + j] = (bf16)f2bf(v); }
                    }
                }
            }
            LDS_WAIT();
            float Tc[64];
#pragma unroll
            for (int i = 0; i < 64; ++i) {
                float s = (lane == i) ? 1.f : 0.f;
#pragma unroll
                for (int j4 = 0; j4 < (i + 3) / 4; ++j4) {
                    const f32x4 a = *(const LAS f32x4*)(Am + i * 64 + j4 * 4);
                    if (j4 * 4 + 0 < i) s -= a.x * Tc[j4 * 4 + 0];
                    if (j4 * 4 + 1 < i) s -= a.y * Tc[j4 * 4 + 1];
                    if (j4 * 4 + 2 < i) s -= a.z * Tc[j4 * 4 + 2];
                    if (j4 * 4 + 3 < i) s -= a.w * Tc[j4 * 4 + 3];
                }
                Tc[i] = s;
            }
#pragma unroll
            for (int i = 0; i < 64; ++i) TP[(size_t)it * 4096 + i * 64 + lane] = (bf16)f2bf(Tc[i] * bt);
            LDS_WAIT();
        }
    }
    xcd_barrier(xbar);

    {
        PHASE_BEGIN
        constexpr int LKG = 0, LQD = 17408, LKDT = 34816, LTP = 53248, LQK = 62464, LST = 71680, LXT = 80384, LVL = 84992, LGL = 90112;
        LAS bf16* Kg = (LAS bf16*)(lds + LKG);
        LAS bf16* Qd = (LAS bf16*)(lds + LQD);
        LAS bf16* KdT = (LAS bf16*)(lds + LKDT);
        LAS bf16* Tp = (LAS bf16*)(lds + LTP);
        LAS bf16* Qk = (LAS bf16*)(lds + LQK);
        LAS bf16* ST = (LAS bf16*)(lds + LST);
        LAS bf16* XT = (LAS bf16*)(lds + LXT);
        LAS bf16* VL = (LAS bf16*)(lds + LVL);
        LAS float* GLw = (LAS float*)(lds + LGL);
        const bf16* TPg = R2; const bf16* QKMg = R2 + (size_t)NCHUNK * 8 * 4096;
        const int n = lane & 15, q = lane >> 4, vl = 16 * (wave & 1) + n;
        const bool cw = wave < 2;
        const int sid = tid - 128;
        const bool two = sid < 128;
#define LBAR() do { asm volatile("s_waitcnt lgkmcnt(0)" ::: "memory"); __builtin_amdgcn_s_barrier(); asm volatile("" ::: "memory"); } while (0)
        int task, tstep;
        if (bid < 128) { task = bid; tstep = 1 << 30; } else { task = 128 + (bid - 128); tstep = G - 128; }
        for (; task < 1152; task += tstep) {
            const bool prm = task < 128; const int tt = prm ? task : task - 128;
            const int c7 = tt & 127, st = (tt & ~127) / 4 + (c7 & 7) * 4 + (c7 >> 5), vq = (c7 >> 3) & 3;
            const int b = st >> 3, h = st & 7;
            const int nch = prm ? 64 : 1; const int cidx0 = prm ? b * 64 : 256 + b;
            const int v = vq * 32 + vl;
            f32x4 Sacc[8];
            if (cw) {
#pragma unroll
                for (int kt = 0; kt < 8; ++kt) {
                    if (prm) Sacc[kt] = (f32x4){0.f, 0.f, 0.f, 0.f};
                    else {
#pragma unroll
                        for (int jj = 0; jj < 4; ++jj) Sacc[kt][jj] = P->state_delta[(((size_t)b * 8 + h) * 128 + 16 * kt + 4 * q + jj) * 128 + v];
                    }
                    u32x2 w; w.x = pk2(Sacc[kt][0], Sacc[kt][1]); w.y = pk2(Sacc[kt][2], Sacc[kt][3]);
                    *(LAS u32x2*)(ST + vl * 136 + 16 * kt + 4 * q) = w;
                }
            }
            u32x4 pq0[2], pq1[2], ptp[2], pqk[2], pvv; unsigned pkw[2][8]; float pgt[2], pgl;
#define SCAN_PREFETCH(cidx_) do { const int r0_ = (cidx_) * 64; const size_t ci_ = (size_t)(cidx_) * 8 + h; \
            _Pragma("unroll") for (int p_ = 0; p_ < 2; ++p_) if (p_ == 0 || two) { const int it_ = sid + 384 * p_, t_ = it_ >> 3, kg_ = it_ & 7; \
                const bf16* qrow_ = R1 + (size_t)(r0_ + t_) * 3072 + h * 128; \
                pq0[p_] = *(const u32x4*)(qrow_ + kg_ * 16); pq1[p_] = *(const u32x4*)(qrow_ + kg_ * 16 + 8); \
                _Pragma("unroll") for (int e_ = 0; e_ < 8; ++e_) pkw[p_][e_] = *(const unsigned*)(qrow_ + 1024 + 2 * kg_ + 16 * e_); \
                ptp[p_] = *(const u32x4*)(TPg + ci_ * 4096 + t_ * 64 + kg_ * 8); pqk[p_] = *(const u32x4*)(QKMg + ci_ * 4096 + t_ * 64 + kg_ * 8); \
                pgt[p_] = GC[ci_ * 64 + t_]; } \
            pgl = GC[ci_ * 64 + 63]; \
            if (sid < 256) pvv = *(const u32x4*)(R1 + (size_t)(r0_ + (sid >> 2)) * 3072 + 2048 + h * 128 + vq * 32 + (sid & 3) * 8); } while (0)
            if (!cw) SCAN_PREFETCH(cidx0);
            for (int ch = 0; ch < nch; ++ch) {
                const int cidx = cidx0 + ch; const int r0 = cidx * 64;
                LBAR();
                if (!cw) {
#pragma unroll
                    for (int p = 0; p < 2; ++p) if (p == 0 || two) {
                        const int it = sid + 384 * p, t = it >> 3, kg = it & 7;
                        const float eg = __expf(pgt[p]), ed = __expf(pgl - pgt[p]);
                        u32x4 o;
                        o.x = pk2(bflo(pq0[p].x) * eg, bfhi(pq0[p].x) * eg); o.y = pk2(bflo(pq0[p].y) * eg, bfhi(pq0[p].y) * eg); o.z = pk2(bflo(pq0[p].z) * eg, bfhi(pq0[p].z) * eg); o.w = pk2(bflo(pq0[p].w) * eg, bfhi(pq0[p].w) * eg);
                        *(LAS u32x4*)(Qd + t * 136 + kg * 16) = o;
                        o.x = pk2(bflo(pq1[p].x) * eg, bfhi(pq1[p].x) * eg); o.y = pk2(bflo(pq1[p].y) * eg, bfhi(pq1[p].y) * eg); o.z = pk2(bflo(pq1[p].z) * eg, bfhi(pq1[p].z) * eg); o.w = pk2(bflo(pq1[p].w) * eg, bfhi(pq1[p].w) * eg);
                        *(LAS u32x4*)(Qd + t * 136 + kg * 16 + 8) = o;
#pragma unroll
                        for (int e = 0; e < 8; ++e) {
                            const int k = 2 * kg + 16 * e; const float lo = bflo(pkw[p][e]), hi = bfhi(pkw[p][e]);
                            *(LAS unsigned*)(Kg + t * 136 + k) = pk2(lo * eg, hi * eg);
                            KdT[k * 72 + t] = (bf16)f2bf(lo * ed); KdT[(k + 1) * 72 + t] = (bf16)f2bf(hi * ed);
                        }
                        *(LAS u32x4*)(Tp + t * 72 + kg * 8) = ptp[p];
                        *(LAS u32x4*)(Qk + t * 72 + kg * 8) = pqk[p];
                    }
                    if (sid < 256) *(LAS u32x4*)(VL + (sid >> 2) * 40 + (sid & 3) * 8) = pvv;
                    if (sid == 0) GLw[0] = __expf(pgl);
                }
                LBAR();
                if (!cw) { if (ch + 1 < nch) SCAN_PREFETCH(cidx + 1); }
                else {
                    const float gl = GLw[0];
                    f32x4 vt[4];
#pragma unroll
                    for (int mt = 0; mt < 4; ++mt)
#pragma unroll
                        for (int jj = 0; jj < 4; ++jj) vt[mt][jj] = bf2f(VL[(16 * mt + 4 * q + jj) * 40 + vl]);
                    f32x4 acc[4] = {{0.f, 0.f, 0.f, 0.f}, {0.f, 0.f, 0.f, 0.f}, {0.f, 0.f, 0.f, 0.f}, {0.f, 0.f, 0.f, 0.f}};
                    bf16x8 sfr[4];
#pragma unroll
                    for (int ks = 0; ks < 4; ++ks) sfr[ks] = *(const LAS bf16x8*)(ST + vl * 136 + 32 * ks + 8 * q);
#pragma unroll
                    for (int mt = 0; mt < 4; ++mt)
#pragma unroll
                        for (int ks = 0; ks < 4; ++ks) {
                            const bf16x8 a = *(const LAS bf16x8*)(Kg + (16 * mt + n) * 136 + 32 * ks + 8 * q);
                            acc[mt] = __builtin_amdgcn_mfma_f32_16x16x32_bf16(a, sfr[ks], acc[mt], 0, 0, 0);
                        }
#pragma unroll
                    for (int mt = 0; mt < 4; ++mt) { const f32x4 d = vt[mt] - acc[mt]; u32x2 w; w.x = pk2(d[0], d[1]); w.y = pk2(d[2], d[3]); *(LAS u32x2*)(XT + vl * 72 + 16 * mt + 4 * q) = w; }
                    f32x4 vn[4] = {{0.f, 0.f, 0.f, 0.f}, {0.f, 0.f, 0.f, 0.f}, {0.f, 0.f, 0.f, 0.f}, {0.f, 0.f, 0.f, 0.f}};
                    bf16x8 xf[2];
#pragma unroll
                    for (int ks = 0; ks < 2; ++ks) xf[ks] = *(const LAS bf16x8*)(XT + vl * 72 + 32 * ks + 8 * q);
#pragma unroll
                    for (int mt = 0; mt < 4; ++mt)
#pragma unroll
                        for (int ks = 0; ks < 2; ++ks) {
                            const bf16x8 a = *(const LAS bf16x8*)(Tp + (16 * mt + n) * 72 + 32 * ks + 8 * q);
                            vn[mt] = __builtin_amdgcn_mfma_f32_16x16x32_bf16(a, xf[ks], vn[mt], 0, 0, 0);
                        }
#pragma unroll
                    for (int mt = 0; mt < 4; ++mt) { u32x2 w; w.x = pk2(vn[mt][0], vn[mt][1]); w.y = pk2(vn[mt][2], vn[mt][3]); *(LAS u32x2*)(XT + vl * 72 + 16 * mt + 4 * q) = w; }
#pragma unroll
                    for (int ks = 0; ks < 2; ++ks) xf[ks] = *(const LAS bf16x8*)(XT + vl * 72 + 32 * ks + 8 * q);
#pragma unroll
                    for (int kt = 0; kt < 8; ++kt) {
                        Sacc[kt] = Sacc[kt] * gl;
#pragma unroll
                        for (int ks = 0; ks < 2; ++ks) {
                            const bf16x8 a = *(const LAS bf16x8*)(KdT + (16 * kt + n) * 72 + 32 * ks + 8 * q);
                            Sacc[kt] = __builtin_amdgcn_mfma_f32_16x16x32_bf16(a, xf[ks], Sacc[kt], 0, 0, 0);
                        }
                        u32x2 w; w.x = pk2(Sacc[kt][0], Sacc[kt][1]); w.y = pk2(Sacc[kt][2], Sacc[kt][3]);
                        *(LAS u32x2*)(ST + vl * 136 + 16 * kt + 4 * q) = w;
                    }
                    f32x4 oo[4] = {{0.f, 0.f, 0.f, 0.f}, {0.f, 0.f, 0.f, 0.f}, {0.f, 0.f, 0.f, 0.f}, {0.f, 0.f, 0.f, 0.f}};
#pragma unroll
                    for (int mt = 0; mt < 4; ++mt) {
#pragma unroll
                        for (int ks = 0; ks < 4; ++ks) {
                            const bf16x8 a = *(const LAS bf16x8*)(Qd + (16 * mt + n) * 136 + 32 * ks + 8 * q);
                            oo[mt] = __builtin_amdgcn_mfma_f32_16x16x32_bf16(a, sfr[ks], oo[mt], 0, 0, 0);
                        }
#pragma unroll
                        for (int ks = 0; ks < 2; ++ks) {
                            const bf16x8 a = *(const LAS bf16x8*)(Qk + (16 * mt + n) * 72 + 32 * ks + 8 * q);
                            oo[mt] = __builtin_amdgcn_mfma_f32_16x16x32_bf16(a, xf[ks], oo[mt], 0, 0, 0);
                        }
                    }
#pragma unroll
                    for (int mt = 0; mt < 4; ++mt)
#pragma unroll
                        for (int jj = 0; jj < 4; ++jj) OB[(size_t)(r0 + 16 * mt + 4 * q + jj) * D + h * 128 + v] = (bf16)f2bf(oo[mt][jj]);
                }
            }
            if (cw) {
                float* dsto = P->out + (prm ? O_DELTA_P : O_DELTA_S) + ((size_t)b * 8 + h) * 16384;
#pragma unroll
                for (int kt = 0; kt < 8; ++kt)
#pragma unroll
                    for (int jj = 0; jj < 4; ++jj) dsto[(size_t)(16 * kt + 4 * q + jj) * 128 + v] = Sacc[kt][jj];
            }
        }
#undef SCAN_PREFETCH
        if (bid >= 128) {
            LBAR();
            SchedScanG S; S.XNp = XN; S.Bz = WIN + (size_t)6144 * D; S.Bgb = WIN + (size_t)8192 * D; S.Bga = WIN + (size_t)7168 * D; S.c = bid - 128;
            pg8::gemm_phase(lds, D, D, S, E);
        }
    }
    xcd_barrier(xbar);

    {
        PHASE_BEGIN
        for (int r = gw; r < MTOK; r += NGW) {
#pragma unroll
            for (int hf = 0; hf < 2; ++hf) {
                const size_t o = (size_t)r * D + hf * 512 + lane * 8;
                const u32x4 ov = *(const u32x4*)(OB + o), zv = *(const u32x4*)(ZB + o);
                float x[8] = {bflo(ov.x), bfhi(ov.x), bflo(ov.y), bfhi(ov.y), bflo(ov.z), bfhi(ov.z), bflo(ov.w), bfhi(ov.w)};
                const float z[8] = {bflo(zv.x), bfhi(zv.x), bflo(zv.y), bfhi(zv.y), bflo(zv.z), bfhi(zv.z), bflo(zv.w), bfhi(zv.w)};
                float s = 0.f;
#pragma unroll
                for (int e = 0; e < 8; ++e) s += x[e] * x[e];
                s = row16_sum(s);
                const float rs = __builtin_amdgcn_rsqf(s * (1.f / 128.f) + EPS);
                const float* gp = P->out_norm_g + (lane & 15) * 8;
                const f32x4 g0 = *(const f32x4*)gp, g1 = *(const f32x4*)(gp + 4);
                u32x4 w;
                w.x = pk2(x[0] * rs * g0[0] * z[0], x[1] * rs * g0[1] * z[1]); w.y = pk2(x[2] * rs * g0[2] * z[2], x[3] * rs * g0[3] * z[3]);
                w.z = pk2(x[4] * rs * g1[0] * z[4], x[5] * rs * g1[1] * z[5]); w.w = pk2(x[6] * rs * g1[2] * z[6], x[7] * rs * g1[3] * z[7]);
                *(u32x4*)(OB + o) = w;
            }
        }
    }
    xcd_barrier(xbar);

    {
        PHASE_BEGIN
        SchedPair64 SP; SP.A0 = OB; SP.B0 = WB; SP.k0 = K_YB; SP.A1 = XN; SP.B1 = WIN + (size_t)8192 * D; SP.k1 = K_GB; SP.G = G; SP.c = bid;
        pg8::gemm_phase(lds, D, D, SP, E);
        SchedSlice T; T.A = OB; T.B = WB; T.kind = K_YBS; T.G = G; T.c = bid; T.ld = D; T.ks = 128;
        pg8::gemm_phase(lds, 128, D, T, E);
    }
    xcd_barrier(xbar);
    {
        PHASE_BEGIN
        for (int i = bid * 512 + tid; i < 2048 * D / 8; i += G * 512) {
            bf16* ym = R3 + (size_t)MPROMPT * D + (size_t)i * 8;
            u32x4 pw[8];
#pragma unroll
            for (int sl = 0; sl < 8; ++sl) pw[sl] = *(const u32x4*)(R1 + (size_t)sl * 2048 * D + (size_t)i * 8);
            const u32x4 y = *(const u32x4*)ym;
            float a[8] = {bflo(y.x), bfhi(y.x), bflo(y.y), bfhi(y.y), bflo(y.z), bfhi(y.z), bflo(y.w), bfhi(y.w)};
#pragma unroll
            for (int sl = 0; sl < 8; ++sl) { a[0] += bflo(pw[sl].x); a[1] += bfhi(pw[sl].x); a[2] += bflo(pw[sl].y); a[3] += bfhi(pw[sl].y); a[4] += bflo(pw[sl].z); a[5] += bfhi(pw[sl].z); a[6] += bflo(pw[sl].w); a[7] += bfhi(pw[sl].w); }
            u32x4 w; w.x = pk2(a[0], a[1]); w.y = pk2(a[2], a[3]); w.z = pk2(a[4], a[5]); w.w = pk2(a[6], a[7]);
            *(u32x4*)ym = w;
        }
    }
    xcd_barrier(xbar);

    {
        PHASE_BEGIN
        SchedFull64 S; S.A = R3; S.B = WO; S.kind = K_O; S.G = G; S.c = bid; S.ld = D;
        pg8::gemm_phase(lds, D, D, S, E);
        SchedSlice T; T.A = R3; T.B = WO; T.kind = K_OS; T.G = G; T.c = bid; T.ld = D; T.ks = 128;
        pg8::gemm_phase(lds, 128, D, T, E);
    }
    xcd_barrier(xbar);

    {
        PHASE_BEGIN
        norm_phase<1>(P, ws, gw, NGW, lane);
        LAS float* scr = (LAS float*)(lds + wave * 8448);
        for (int base = gw; base < 4096; base += 2 * NGW) {
            TrItem t0 = tr_decode1(P, ws, base), t1 = t0; f32x4 v0[8], v1[8];
            const bool h1 = base + NGW < 4096;
            transpose_load(t0, v0, lane);
            if (h1) { t1 = tr_decode1(P, ws, base + NGW); transpose_load(t1, v1, lane); }
            transpose_finish(t0, v0, scr, lane);
            if (h1) transpose_finish(t1, v1, scr, lane);
        }
    }
    xcd_barrier(xbar);

    {
        PHASE_BEGIN
        SchedFlat S; S.A0 = S.A1 = S.A2 = XN; S.B0 = S.B1 = S.B2 = WFF1; S.n0 = 16; S.n1 = 0; S.n2 = 0; S.k0 = S.k1 = S.k2 = K_FF1; S.nN = 16; S.G = G; S.c = bid; S.K = D;
        pg8::gemm_phase(lds, D, D, S, E);
    }
    xcd_barrier(xbar);

    {
        PHASE_BEGIN
        SchedFull64 S; S.A = R1; S.B = WFF2; S.kind = K_FF2; S.G = G; S.c = bid; S.ld = FF;
        pg8::gemm_phase(lds, FF, FF, S, E);
        SchedSlice T; T.A = R1; T.B = WFF2; T.kind = K_FF2S; T.G = G; T.c = bid; T.ld = FF; T.ks = 512;
        pg8::gemm_phase(lds, 512, FF, T, E);
    }
    xcd_barrier(xbar);

    { PHASE_BEGIN
      norm_phase<2>(P, ws, gw, NGW, lane); }
}

extern "C" void kernel_launch(void* const* d_in, const int* in_sizes, int n_in, void* d_out, int out_size, void* d_ws, size_t ws_size, hipStream_t stream) {
    static int grid_blocks = 0;
    if (grid_blocks == 0) {
        if (n_in != 25 || ws_size < WS_END) { fprintf(stderr, "kernel_launch: unexpected n_in %d / ws_size %zu\n", n_in, ws_size); grid_blocks = -1; return; }
        int dev = 0, cus = 0, per_cu = 0;
        hipGetDevice(&dev);
        hipDeviceGetAttribute(&cus, hipDeviceAttributeMultiprocessorCount, dev);
        if (hipFuncSetAttribute((const void*)mega_fwd, hipFuncAttributeMaxDynamicSharedMemorySize, LDS_BYTES) != hipSuccess) { fprintf(stderr, "kernel_launch: hipFuncSetAttribute failed\n"); grid_blocks = -1; return; }
        hipOccupancyMaxActiveBlocksPerMultiprocessor(&per_cu, (const void*)mega_fwd, 512, LDS_BYTES);
        if (per_cu < 1) { fprintf(stderr, "kernel_launch: occupancy query gave %d\n", per_cu); per_cu = 1; }
        (void)hipGetLastError();
        grid_blocks = cus;
        if (cus != 256) { fprintf(stderr, "kernel_launch: the unit schedules are written for 256 CUs, found %d\n", cus); grid_blocks = -1; return; }
        fprintf(stderr, "kernel_launch: grid %d (per_cu %d), ws %zu\n", grid_blocks, per_cu, ws_size);
    }
    if (grid_blocks < 0) return;
    Params p{};
    const float** pp = (const float**)&p;
    for (int i = 0; i < 25; ++i) pp[i] = (const float*)d_in[i];
    p.out = (float*)d_out; p.ws = (unsigned char*)d_ws;
    if (hipMemsetAsync((char*)d_ws + WS_BAR, 0, BAR_BYTES, stream) != hipSuccess) { fprintf(stderr, "kernel_launch: memset of the barrier words failed\n"); return; }
    void* args[] = {&p};
    hipError_t e = hipLaunchCooperativeKernel((const void*)mega_fwd, dim3(grid_blocks), dim3(512), args, LDS_BYTES, stream);
    if (e != hipSuccess) fprintf(stderr, "cooperative launch failed: %s (grid %d)\n", hipGetErrorString(e), grid_blocks);
}
```
